# Optimizing an MI355X kernel written in HIP

```python
import math
import jax, jax.numpy as jnp
from jax import lax
import numpy as np

D_MODEL = 1024
BATCH = 4
SEQ = 8192
DEPTH = 2

MEM_LEN = 256
HEAD_DIM = 64
SELF_WIDTH = 3 * D_MODEL // 4
N_MOBA_HEADS = SELF_WIDTH // HEAD_DIM
N_DIFF_HEADS = SELF_WIDTH // (2 * HEAD_DIM)
N_MEM_HEADS = 4
MEM_WIDTH = N_MEM_HEADS * HEAD_DIM
A_IN = 3 * SELF_WIDTH + MEM_WIDTH
B_IN = SELF_WIDTH + MEM_WIDTH
D_FF = 4 * D_MODEL
MOBA_BLOCK = 256
MOBA_TOPK = 3
Q_BLOCK = 128
MOBA_Q_CHUNK = 32
ROPE_THETA = 10000.0
EPS = 1e-6
NEG = -1e30
N_A_LAYERS = DEPTH // 2
N_B_LAYERS = DEPTH - N_A_LAYERS

kernel_name = "yoco_diffattn_moba_hybrid"


def _rmsnorm(x, g):
    xf = x.astype(jnp.float32)
    y = xf * lax.rsqrt(jnp.mean(xf * xf, axis=-1, keepdims=True) + EPS)
    return (y * g.astype(jnp.float32)).astype(x.dtype)


def _rope_tables(n):
    half = HEAD_DIM // 2
    inv = 1.0 / (ROPE_THETA ** (jnp.arange(half, dtype=jnp.float32) / half))
    ang = jnp.arange(n, dtype=jnp.float32)[:, None] * inv[None, :]
    return jnp.cos(ang), jnp.sin(ang)


def _apply_rope(x, cos, sin):
    half = HEAD_DIM // 2
    shp = (x.shape[1],) + (1,) * (x.ndim - 3) + (half,)
    c = cos.reshape(shp)
    s = sin.reshape(shp)
    xf = x.astype(jnp.float32)
    x1, x2 = xf[..., :half], xf[..., half:]
    return jnp.concatenate([x1 * c - x2 * s, x2 * c + x1 * s], axis=-1).astype(x.dtype)


def _sq_relu_mlp(h, w_up, w_down):
    u = jax.nn.relu(h @ w_up)
    return (u * u) @ w_down


def _memory_attention(qm, mem, mem_norm, w_mem_kv):
    B, S = qm.shape[:2]
    M = mem.shape[1]
    kv = _rmsnorm(mem, mem_norm) @ w_mem_kv
    mk = kv[..., :MEM_WIDTH].reshape(B, M, N_MEM_HEADS, HEAD_DIM).astype(jnp.float32)
    mv = kv[..., MEM_WIDTH:].reshape(B, M, N_MEM_HEADS, HEAD_DIM).astype(jnp.float32)
    s = jnp.einsum('bshd,bmhd->bhsm', qm.astype(jnp.float32), mk) * (HEAD_DIM ** -0.5)
    p = jax.nn.softmax(s, axis=-1)
    o = jnp.einsum('bhsm,bmhd->bshd', p, mv)
    return o.reshape(B, S, MEM_WIDTH).astype(qm.dtype)


def _diff_attention(q, k, v, lam, lam_init, subln):
    B, S, H, _, d = q.shape
    nq = S // Q_BLOCK
    kf = k.astype(jnp.float32)
    vf = v.astype(jnp.float32)
    qb = q.astype(jnp.float32).reshape(B, nq, Q_BLOCK, H, 2, d).transpose(1, 0, 2, 3, 4, 5)
    kpos = jnp.arange(S)
    scale = d ** -0.5

    def block(args):
        qi, i = args
        s = jnp.einsum('bqhcd,bkhcd->bhcqk', qi, kf) * scale
        qpos = i * Q_BLOCK + jnp.arange(Q_BLOCK)
        s = jnp.where(kpos[None, :] <= qpos[:, None], s, NEG)
        p = jax.nn.softmax(s, axis=-1)
        w = p[:, :, 0] - lam * p[:, :, 1]
        return jnp.einsum('bhqk,bkhe->bqhe', w, vf)

    o = lax.map(block, (qb, jnp.arange(nq)))
    o = o.transpose(1, 0, 2, 3, 4).reshape(B, S, H, 2 * d)
    o = _rmsnorm(o, subln) * (1.0 - lam_init)
    return o.reshape(B, S, H * 2 * d).astype(v.dtype)


def _moba_attention(q, kbh, vbh, kmean):
    B, S, H, d = q.shape
    NB = kbh.shape[2]
    ksel = min(MOBA_TOPK, NB)
    C = MOBA_Q_CHUNK
    nc = S // C
    qc = q.astype(jnp.float32).transpose(0, 2, 1, 3).reshape(B, H, nc, C, d).transpose(2, 0, 1, 3, 4)
    b_ix = jnp.arange(B)[:, None, None, None]
    h_ix = jnp.arange(H)[None, :, None, None]
    scale = d ** -0.5

    def chunk(args):
        qi, i = args
        qpos = i * C + jnp.arange(C)
        cur = (i * C) // MOBA_BLOCK
        gate = jnp.einsum('bhqd,bhnd->bhqn', qi, kmean)
        gate = jnp.where(jnp.arange(NB) < cur, gate, NEG)
        _, idx = lax.top_k(gate, ksel)
        valid = idx < cur
        k_sel = kbh[b_ix, h_ix, idx]
        v_sel = vbh[b_ix, h_ix, idx]
        s_sel = jnp.einsum('bhqd,bhqnkd->bhqnk', qi, k_sel) * scale
        s_sel = jnp.where(valid[..., None], s_sel, NEG).reshape(B, H, C, ksel * MOBA_BLOCK)
        k_own = lax.dynamic_index_in_dim(kbh, cur, axis=2, keepdims=False)
        v_own = lax.dynamic_index_in_dim(vbh, cur, axis=2, keepdims=False)
        s_own = jnp.einsum('bhqd,bhkd->bhqk', qi, k_own) * scale
        kpos = cur * MOBA_BLOCK + jnp.arange(MOBA_BLOCK)
        s_own = jnp.where(kpos[None, :] <= qpos[:, None], s_own, NEG)
        p = jax.nn.softmax(jnp.concatenate([s_sel, s_own], axis=-1), axis=-1)
        p_sel = p[..., :ksel * MOBA_BLOCK].reshape(B, H, C, ksel, MOBA_BLOCK)
        p_own = p[..., ksel * MOBA_BLOCK:]
        return (jnp.einsum('bhqnk,bhqnkd->bhqd', p_sel, v_sel)
                + jnp.einsum('bhqk,bhkd->bhqd', p_own, v_own))

    o = lax.map(chunk, (qc, jnp.arange(nc)))
    return o.transpose(1, 0, 3, 2, 4).reshape(B, S, H * d).astype(q.dtype)


def setup_inputs(seed: int = 0) -> dict:
    key = jax.random.key(seed)
    ks = iter(jax.random.split(key, 40))

    def nrm(shape, scale):
        return jax.random.normal(next(ks), shape, jnp.float32) * scale

    def gain(shape):
        return 1.0 + nrm(shape, 0.02)

    NA, NBL, D = N_A_LAYERS, N_B_LAYERS, D_MODEL
    return {
        "x": nrm((BATCH, SEQ, D), 1.0),
        "mem": nrm((BATCH, MEM_LEN, D), 1.0),
        "a_norm_attn": gain((NA, D)),
        "a_w_in": nrm((NA, D, A_IN), D ** -0.5),
        "a_lambda": nrm((NA, 4, HEAD_DIM), 0.1),
        "a_subln": gain((NA, 2 * HEAD_DIM)),
        "a_mem_norm": gain((NA, D)),
        "a_w_mem_kv": nrm((NA, D, 2 * MEM_WIDTH), D ** -0.5),
        "a_w_out": nrm((NA, D, D), D ** -0.5),
        "a_norm_mlp": gain((NA, D)),
        "a_w_up": nrm((NA, D, D_FF), D ** -0.5),
        "a_w_down": nrm((NA, D_FF, D), D_FF ** -0.5),
        "kv_norm": gain((D,)),
        "w_kv": nrm((D, 2 * SELF_WIDTH), D ** -0.5),
        "b_norm_attn": gain((NBL, D)),
        "b_w_in": nrm((NBL, D, B_IN), D ** -0.5),
        "b_mem_norm": gain((NBL, D)),
        "b_w_mem_kv": nrm((NBL, D, 2 * MEM_WIDTH), D ** -0.5),
        "b_w_out": nrm((NBL, D, D), D ** -0.5),
        "b_norm_mlp": gain((NBL, D)),
        "b_w_up": nrm((NBL, D, D_FF), D ** -0.5),
        "b_w_down": nrm((NBL, D_FF, D), D_FF ** -0.5),
        "final_norm": gain((D,)),
    }


def reference(x, mem, a_norm_attn, a_w_in, a_lambda, a_subln, a_mem_norm, a_w_mem_kv,
              a_w_out, a_norm_mlp, a_w_up, a_w_down, kv_norm, w_kv, b_norm_attn, b_w_in,
              b_mem_norm, b_w_mem_kv, b_w_out, b_norm_mlp, b_w_up, b_w_down, final_norm):
    B, S, _ = x.shape
    cos, sin = _rope_tables(S)
    kbh = vbh = kmean = None
    for layer in range(DEPTH):
        if layer < N_A_LAYERS:
            i = layer
            h = _rmsnorm(x, a_norm_attn[i])
            z = h @ a_w_in[i]
            w = SELF_WIDTH
            q = z[..., :w].reshape(B, S, N_DIFF_HEADS, 2, HEAD_DIM)
            k = z[..., w:2 * w].reshape(B, S, N_DIFF_HEADS, 2, HEAD_DIM)
            v = z[..., 2 * w:3 * w].reshape(B, S, N_DIFF_HEADS, 2 * HEAD_DIM)
            qm = z[..., 3 * w:].reshape(B, S, N_MEM_HEADS, HEAD_DIM)
            q = _apply_rope(q, cos, sin)
            k = _apply_rope(k, cos, sin)
            lam_init = 0.8 - 0.6 * math.exp(-0.3 * layer)
            lp = a_lambda[i].astype(jnp.float32)
            lam = jnp.exp(jnp.sum(lp[0] * lp[1])) - jnp.exp(jnp.sum(lp[2] * lp[3])) + lam_init
            o_self = _diff_attention(q, k, v, lam, lam_init, a_subln[i])
            o_mem = _memory_attention(qm, mem, a_mem_norm[i], a_w_mem_kv[i])
            x = x + jnp.concatenate([o_self, o_mem], axis=-1) @ a_w_out[i]
            x = x + _sq_relu_mlp(_rmsnorm(x, a_norm_mlp[i]), a_w_up[i], a_w_down[i])
        else:
            j = layer - N_A_LAYERS
            if j == 0:
                hk = _rmsnorm(x, kv_norm)
                kv = hk @ w_kv
                ks_ = _apply_rope(kv[..., :SELF_WIDTH].reshape(B, S, N_MOBA_HEADS, HEAD_DIM), cos, sin)
                vs_ = kv[..., SELF_WIDTH:].reshape(B, S, N_MOBA_HEADS, HEAD_DIM)
                n_blk = -(-S // MOBA_BLOCK)
                pad = n_blk * MOBA_BLOCK - S
                padw = ((0, 0), (0, pad), (0, 0), (0, 0))
                kbh = jnp.pad(ks_.astype(jnp.float32), padw).reshape(
                    B, n_blk, MOBA_BLOCK, N_MOBA_HEADS, HEAD_DIM).transpose(0, 3, 1, 2, 4)
                vbh = jnp.pad(vs_.astype(jnp.float32), padw).reshape(
                    B, n_blk, MOBA_BLOCK, N_MOBA_HEADS, HEAD_DIM).transpose(0, 3, 1, 2, 4)
                kmean = jnp.mean(kbh, axis=3)
            h = _rmsnorm(x, b_norm_attn[j])
            z = h @ b_w_in[j]
            q = _apply_rope(z[..., :SELF_WIDTH].reshape(B, S, N_MOBA_HEADS, HEAD_DIM), cos, sin)
            qm = z[..., SELF_WIDTH:].reshape(B, S, N_MEM_HEADS, HEAD_DIM)
            o_self = _moba_attention(q, kbh, vbh, kmean).astype(x.dtype)
            o_mem = _memory_attention(qm, mem, b_mem_norm[j], b_w_mem_kv[j])
            x = x + jnp.concatenate([o_self, o_mem], axis=-1) @ b_w_out[j]
            x = x + _sq_relu_mlp(_rmsnorm(x, b_norm_mlp[j]), b_w_up[j], b_w_down[j])
    return _rmsnorm(x, final_norm)
```

```cpp
#include <hip/hip_runtime.h>
#include <hip/hip_cooperative_groups.h>
#include <cmath>
namespace cg = cooperative_groups;
#include <hip/hip_runtime.h>
#include <cstdio>
#include <cstdint>
namespace pg8 {
#define PG8_LAS __attribute__((address_space(3)))
typedef unsigned short bf16_t;
typedef short bf16x8 __attribute__((ext_vector_type(8)));
typedef float f32x4 __attribute__((ext_vector_type(4)));
typedef unsigned u32x4 __attribute__((ext_vector_type(4)));
constexpr int BM = 256, BK = 64, HALF = 128, HTB = HALF * BK * 2  , STAGE_BYTES = 8 * HTB, NXCD = 8, WGM = 8;

__host__ __device__ __forceinline__ int lds_byte(int r, int c) { const int st = (r >> 4) * 2 + (c >> 5), rr = r & 15, cc = c & 31, ob = rr * 64 + cc * 2; return st * 1024 + (ob ^ (((ob >> 9) & 1) << 5)); }
__host__ __device__ __forceinline__ void stage_rc(int b, int& R, int& C) { const int st = b / 1024, sb = b % 1024, swz = sb ^ (((sb >> 9) & 1) << 5); R = (st >> 1) * 16 + swz / 64; C = (st & 1) * 32 + (swz % 64) / 2; }
__host__ __device__ __forceinline__ int perm32(int rho) { const int n = rho >> 4, i = rho & 15; return 8 * (i >> 2) + 4 * n + (i & 3); }

struct Unit { int pm, pn; };
struct Gemm { const bf16_t* A; const bf16_t* Bt; int M, N, K; };

struct StaticOrder {
    int nM, nN, nwg, G, c;
    __host__ __device__ void init(int M, int N, int G_, int c_) { nM = M / BM; nN = N / BM; nwg = nM * nN; G = G_; c = c_; }
    __host__ __device__ bool next(int i, Unit& u) const {
        const long L = (long)i * G + c; if (L >= nwg) return false;
        int wgid = (int)L; { const int q = nwg / NXCD, r = nwg % NXCD, xcd = wgid % NXCD, off = wgid / NXCD; wgid = (xcd < r ? xcd * (q + 1) : r * (q + 1) + (xcd - r) * q) + off; }
        const int nig = WGM * nN, gid = wgid / nig, fm = gid * WGM, gsz = (nM - fm) < WGM ? (nM - fm) : WGM;
        u.pm = fm + ((wgid % nig) % gsz); u.pn = (wgid % nig) / gsz; return true;
    }
    __device__ __forceinline__ void a_ready(const Unit&) const {}
    __device__ __forceinline__ void done(const Unit&) const {}
};

typedef float f32x2_t __attribute__((ext_vector_type(2))); typedef __bf16 bf16x2_t __attribute__((ext_vector_type(2)));
typedef unsigned u32x2 __attribute__((ext_vector_type(2)));
__device__ __forceinline__ unsigned cvtpk(float lo, float hi) { f32x2_t v = {lo, hi}; bf16x2_t b = __builtin_convertvector(v, bf16x2_t); return __builtin_bit_cast(unsigned, b); }
__device__ __forceinline__ u32x2 pk4(const f32x4 v) { u32x2 w; w.x = cvtpk(v[0], v[1]); w.y = cvtpk(v[2], v[3]); return w; }
constexpr float RMS_EPS = 1e-6f;
__device__ __forceinline__ float rstd_of(float ss) { return 1.0f / sqrtf(ss * (1.0f / 1024.0f) + RMS_EPS); }

struct EpiInB {
    static constexpr bool PERM = false, AFTER_DRAIN = false;
    bf16_t *Kf, *Q, *QM; float* kms; const float* ss; const float* cs; const float* sn; float c2;
    __device__ __forceinline__ void operator()(const f32x4 (&acc)[2][2][4][2], const Unit& u, int wr, int wc, int fr, int fq) const {
        const int tile = u.pn, row0 = u.pm * BM + wr * 64 + fr;
        if (tile < 6) {
            const bool isk = tile < 3; const float sc = isk ? 1.f : c2; const int d1 = (wc & 1) * 16 + fq * 4;
            f32x4 cs1[2] = {{0.f, 0.f, 0.f, 0.f}, {0.f, 0.f, 0.f, 0.f}}, cs2[2] = {{0.f, 0.f, 0.f, 0.f}, {0.f, 0.f, 0.f, 0.f}};
#pragma unroll
            for (int ai = 0; ai < 2; ++ai)
#pragma unroll
                for (int m = 0; m < 4; ++m) { const int row = row0 + ai * HALF + m * 16, pos = row & 8191, b = row >> 13; const float rs = rstd_of(ss[row]) * sc;
                    const f32x4 c4 = *(const f32x4*)(cs + pos * 32 + d1), s4 = *(const f32x4*)(sn + pos * 32 + d1);
#pragma unroll
                    for (int bj = 0; bj < 2; ++bj) { const f32x4 x1 = acc[ai][bj][m][0] * rs, x2 = acc[ai][bj][m][1] * rs;
                        const f32x4 o1 = x1 * c4 - x2 * s4, o2 = x2 * c4 + x1 * s4;
                        const int hl = bj * 2 + (wc >> 1);
                        if (isk) { const int h = tile * 4 + hl; if (kms) { cs1[bj] += o1; cs2[bj] += o2; }
                            bf16_t* p = Kf + (size_t)(b * 12 + h) * (8192 * 64) + ((size_t)((pos >> 5) * 4 + (wc & 1)) * 64 + (fq >> 1) * 32 + (pos & 31)) * 8 + (fq & 1) * 4;
                            *(u32x2*)p = pk4(o1); *(u32x2*)(p + 2 * 512) = pk4(o2); }
                        else { bf16_t* p = Q + (size_t)row * 768 + (tile - 3) * 256 + hl * 64 + d1; *(u32x2*)p = pk4(o1); *(u32x2*)(p + 32) = pk4(o2); } } }
            if (isk && kms) {
                const int b = u.pm >> 5, blk = u.pm & 31;
#pragma unroll
                for (int bj = 0; bj < 2; ++bj)
#pragma unroll
                    for (int j = 0; j < 4; ++j) { float a = cs1[bj][j], c = cs2[bj][j];
#pragma unroll
                        for (int o = 1; o < 16; o <<= 1) { a += __shfl_xor(a, o); c += __shfl_xor(c, o); }
                        if (fr == 0) { const int h = tile * 4 + bj * 2 + (wc >> 1); float* p = kms + ((size_t)((b * 12 + h) * 32 + blk)) * 64 + d1 + j; atomicAdd(p, a); atomicAdd(p + 32, c); } }
            }
        } else {
#pragma unroll
            for (int ai = 0; ai < 2; ++ai)
#pragma unroll
                for (int m = 0; m < 4; ++m) { const int row = row0 + ai * HALF + m * 16; const float rs = rstd_of(ss[row]) * c2;
#pragma unroll
                    for (int bj = 0; bj < 2; ++bj)
#pragma unroll
                        for (int n = 0; n < 2; ++n) *(u32x2*)(QM + (size_t)row * 256 + bj * HALF + wc * 32 + n * 16 + fq * 4) = pk4(acc[ai][bj][m][n] * rs); }
        }
    }
};
struct EpiMemK {
    static constexpr bool PERM = false, AFTER_DRAIN = false;
    bf16_t* Kf; const float* ss;
    __device__ __forceinline__ void operator()(const f32x4 (&acc)[2][2][4][2], const Unit& u, int wr, int wc, int fr, int fq) const {
        const int row0 = u.pm * BM + wr * 64 + fr;
#pragma unroll
        for (int ai = 0; ai < 2; ++ai)
#pragma unroll
            for (int m = 0; m < 4; ++m) { const int row = row0 + ai * HALF + m * 16, b = row >> 8, key = row & 255; const float rs = rstd_of(ss[row]);
#pragma unroll
                for (int bj = 0; bj < 2; ++bj)
#pragma unroll
                    for (int n = 0; n < 2; ++n) { const int head = bj * 2 + (wc >> 1), ks = (wc & 1) * 2 + n;
                        bf16_t* p = Kf + (size_t)(b * 4 + head) * (256 * 64) + ((size_t)((key >> 5) * 4 + ks) * 64 + (fq >> 1) * 32 + (key & 31)) * 8 + (fq & 1) * 4;
                        *(u32x2*)p = pk4(acc[ai][bj][m][n] * rs); } }
    }
};
template <int LOGSEQ, int NH, int LOGD> struct EpiVt {
    static constexpr bool PERM = false, AFTER_DRAIN = false;
    bf16_t* Vf; const float* ss;
    __device__ __forceinline__ void operator()(const f32x4 (&acc)[2][2][4][2], const Unit& u, int wr, int wc, int fr, int fq) const {
        const int f0 = u.pm * BM + wr * 64 + fr, c0 = u.pn * BM + wc * 32 + fq * 4;
#pragma unroll
        for (int bj = 0; bj < 2; ++bj)
#pragma unroll
            for (int n = 0; n < 2; ++n) { const int c = c0 + bj * HALF + n * 16, b = c >> LOGSEQ, key = c & ((1 << LOGSEQ) - 1);
                const f32x4 s4 = *(const f32x4*)(ss + c); f32x4 rs; rs[0] = rstd_of(s4[0]); rs[1] = rstd_of(s4[1]); rs[2] = rstd_of(s4[2]); rs[3] = rstd_of(s4[3]);
#pragma unroll
                for (int ai = 0; ai < 2; ++ai)
#pragma unroll
                    for (int m = 0; m < 4; ++m) { const int f = f0 + ai * HALF + m * 16, head = f >> LOGD, d = f & ((1 << LOGD) - 1);
                        bf16_t* p = Vf + ((size_t)(b * NH + head) << (LOGSEQ + LOGD)) + ((size_t)(((key >> 5) * 2 + n) * (1 << (LOGD - 5)) + (d >> 5)) * 64 + (fq & 1) * 32 + (d & 31)) * 8 + (fq >> 1) * 4;
                        *(u32x2*)p = pk4(acc[ai][bj][m][n] * rs); } }
    }
};
struct EpiRes {
    static constexpr bool PERM = false, AFTER_DRAIN = false;
    const float* xin; float* xout; bf16_t* x16; float* ssout;
    __device__ __forceinline__ void operator()(const f32x4 (&acc)[2][2][4][2], const Unit& u, int wr, int wc, int fr, int fq) const {
        const int row0 = u.pm * BM + wr * 64 + fr, col0 = u.pn * BM + wc * 32 + fq * 4;
#pragma unroll
        for (int ai = 0; ai < 2; ++ai)
#pragma unroll
            for (int m = 0; m < 4; ++m) { const int row = row0 + ai * HALF + m * 16; float q = 0.f;
#pragma unroll
                for (int bj = 0; bj < 2; ++bj)
#pragma unroll
                    for (int n = 0; n < 2; ++n) { const size_t off = (size_t)row * 1024 + col0 + bj * HALF + n * 16;
                        const f32x4 v = *(const f32x4*)(xin + off) + acc[ai][bj][m][n];
                        *(f32x4*)(xout + off) = v; *(u32x2*)(x16 + off) = pk4(v); q += (v[0] * v[0] + v[1] * v[1]) + (v[2] * v[2] + v[3] * v[3]); }
                q += __shfl_xor(q, 16); q += __shfl_xor(q, 32);
                if (fq == 0) atomicAdd(ssout + row, q); }
    }
};
struct EpiUp {
    static constexpr bool PERM = false, AFTER_DRAIN = false;
    bf16_t* H; const float* ss;
    __device__ __forceinline__ void operator()(const f32x4 (&acc)[2][2][4][2], const Unit& u, int wr, int wc, int fr, int fq) const {
        const int row0 = u.pm * BM + wr * 64 + fr, col0 = u.pn * BM + wc * 32 + fq * 4;
#pragma unroll
        for (int ai = 0; ai < 2; ++ai)
#pragma unroll
            for (int m = 0; m < 4; ++m) { const int row = row0 + ai * HALF + m * 16; const float rs = rstd_of(ss[row]);
#pragma unroll
                for (int bj = 0; bj < 2; ++bj)
#pragma unroll
                    for (int n = 0; n < 2; ++n) { f32x4 v = acc[ai][bj][m][n] * rs; v = __builtin_elementwise_max(v, (f32x4){0.f, 0.f, 0.f, 0.f}); v = v * v;
                        *(u32x2*)(H + (size_t)row * 4096 + col0 + bj * HALF + n * 16) = pk4(v); } }
    }
};
template <class Epi, class Sched, bool ALIGN_EPI = false, bool SP2 = false>
__device__ __forceinline__ void gemm_phase(PG8_LAS unsigned char* lds, const Gemm g, const Sched& S, const Epi& E) {
    const int tid = threadIdx.x, wid = __builtin_amdgcn_readfirstlane(tid >> 6), lane = tid & 63, wr = wid >> 2, wc = wid & 3, fr = lane & 15, fq = lane >> 4;
    const int K = g.K, nt = K / BK;
    unsigned voffA[2], voffB[2];
#pragma unroll
    for (int i = 0; i < 2; ++i) { int R, C; stage_rc(tid * 16 + i * 8192, R, C); const int Rb = Epi::PERM ? ((R & ~31) + perm32(R & 31)) : R;
        voffA[i] = (unsigned)(R * K + C) * 2u; voffB[i] = (unsigned)(Rb * K + C) * 2u; }
    const size_t kstep = (size_t)(BK * 2);
    const size_t hstep = (size_t)HALF * K * 2;
    const size_t tstep = 2 * hstep;
    const unsigned ldsw = (unsigned)wid * 1024u;
    const int aoff = lds_byte(wr * 64 + fr, fq * 8), boff = lds_byte(wc * 32 + fr, fq * 8);
#define PG8_SA(b, h) (((b) * 2 + (h)) * HTB)
#define PG8_SB(b, h) ((4 + (b) * 2 + (h)) * HTB)
#define PG8_STAGE(bufoff, gbase, voff) do { _Pragma("unroll") for (int _i = 0; _i < 2; ++_i) \
        __builtin_amdgcn_global_load_lds((const unsigned*)((const char*)(gbase) + (voff)[_i]), (PG8_LAS unsigned*)(lds + (bufoff) + ldsw + _i * 8192), 16, 0, 0); } while (0)
#define PG8_LDA(dst, b, h) do { _Pragma("unroll") for (int m = 0; m < 4; ++m) _Pragma("unroll") for (int k = 0; k < 2; ++k) dst[m][k] = *(const PG8_LAS bf16x8*)(lds + PG8_SA(b, h) + aoff + m * 2048 + k * 1024); } while (0)
#define PG8_LDB(dst, b, h) do { _Pragma("unroll") for (int n = 0; n < 2; ++n) _Pragma("unroll") for (int k = 0; k < 2; ++k) dst[n][k] = *(const PG8_LAS bf16x8*)(lds + PG8_SB(b, h) + boff + n * 2048 + k * 1024); } while (0)
#define PG8_MMA(ai, bj, At, Bt) do { __builtin_amdgcn_s_setprio(1); _Pragma("unroll") for (int m = 0; m < 4; ++m) _Pragma("unroll") for (int n = 0; n < 2; ++n) _Pragma("unroll") for (int k = 0; k < 2; ++k) \
        acc[ai][bj][m][n] = __builtin_amdgcn_mfma_f32_16x16x32_bf16(Bt[n][k], At[m][k], acc[ai][bj][m][n], 0, 0, 0); __builtin_amdgcn_s_setprio(0); } while (0)
#define PG8_WAIT_V(n) asm volatile("s_waitcnt vmcnt(" #n ")" ::: "memory")
#define PG8_WAIT_L(n) asm volatile("s_waitcnt lgkmcnt(" #n ")" ::: "memory")
#define PG8_BAR __builtin_amdgcn_s_barrier()
#define PG8_SCHED __builtin_amdgcn_sched_barrier(0)
    Unit cur, nxt; int ui = 0;
    if (!S.next(0, cur)) return;
    f32x4 acc[2][2][4][2];
#pragma unroll
    for (int a = 0; a < 2; ++a)
#pragma unroll
        for (int b = 0; b < 2; ++b)
#pragma unroll
            for (int m = 0; m < 4; ++m)
#pragma unroll
                for (int n = 0; n < 2; ++n) acc[a][b][m][n] = (f32x4){0.f, 0.f, 0.f, 0.f};
    bf16x8 At[4][2], B0[2][2], B1[2][2];
    const char* cA = (const char*)g.A + (size_t)cur.pm * tstep; const char* cB = (const char*)g.Bt + (size_t)cur.pn * tstep;
    S.a_ready(cur);
    if constexpr (SP2) {
        PG8_STAGE(PG8_SB(0, 0), cB, voffB); PG8_STAGE(PG8_SB(0, 1), cB + hstep, voffB); PG8_STAGE(PG8_SA(0, 0), cA, voffA); PG8_STAGE(PG8_SA(0, 1), cA + hstep, voffA);
        if (wr == 1) PG8_BAR;
        PG8_WAIT_V(2); PG8_BAR;
        PG8_STAGE(PG8_SB(1, 0), cB + kstep, voffB); PG8_STAGE(PG8_SA(1, 0), cA + kstep, voffA); PG8_STAGE(PG8_SB(1, 1), cB + hstep + kstep, voffB);
        PG8_WAIT_V(6); PG8_BAR;
    } else {
        PG8_STAGE(PG8_SB(0, 0), cB, voffB); PG8_STAGE(PG8_SA(0, 0), cA, voffA); PG8_STAGE(PG8_SB(0, 1), cB + hstep, voffB); PG8_STAGE(PG8_SA(0, 1), cA + hstep, voffA);
        if (wr == 1) PG8_BAR;
        PG8_WAIT_V(4); PG8_BAR;
        PG8_STAGE(PG8_SB(1, 0), cB + kstep, voffB); PG8_STAGE(PG8_SA(1, 0), cA + kstep, voffA); PG8_STAGE(PG8_SB(1, 1), cB + hstep + kstep, voffB);
        PG8_WAIT_V(6); PG8_BAR;
    }
    for (;;) {
        const bool has_next = S.next(ui + 1, nxt);
        const char* nA = has_next ? (const char*)g.A + (size_t)nxt.pm * tstep : cA; const char* nB = has_next ? (const char*)g.Bt + (size_t)nxt.pn * tstep : cB;
        for (int t = 0; t < nt; t += 2) {
            const bool last = (t == nt - 2);
            const char* a1 = cA + (size_t)(t + 1) * kstep;
            const char* a2 = last ? nA : cA + (size_t)(t + 2) * kstep; const char* b2 = last ? nB : cB + (size_t)(t + 2) * kstep;
            const char* a3 = a2 + kstep; const char* b3 = b2 + kstep;
            if (last && has_next) S.a_ready(nxt);
            if constexpr (SP2) {
            PG8_LDB(B0, 0, 0); PG8_LDB(B1, 0, 1); PG8_SCHED; PG8_LDA(At, 0, 0); PG8_STAGE(PG8_SA(1, 1), a1 + hstep, voffA);
            PG8_WAIT_V(8); PG8_WAIT_L(0); PG8_BAR; PG8_MMA(0, 0, At, B0); PG8_MMA(0, 1, At, B1); PG8_BAR; PG8_SCHED;
            PG8_LDA(At, 0, 1); PG8_STAGE(PG8_SB(0, 0), b2, voffB); PG8_STAGE(PG8_SB(0, 1), b2 + hstep, voffB); PG8_STAGE(PG8_SA(0, 0), a2, voffA);
            PG8_WAIT_V(8); PG8_WAIT_L(0); PG8_BAR; PG8_MMA(1, 0, At, B0); PG8_MMA(1, 1, At, B1); PG8_BAR; PG8_SCHED;
            PG8_LDB(B0, 1, 0); PG8_LDB(B1, 1, 1); PG8_SCHED; PG8_LDA(At, 1, 0); PG8_STAGE(PG8_SA(0, 1), a2 + hstep, voffA);
            PG8_WAIT_V(8); PG8_WAIT_L(0); PG8_BAR; PG8_MMA(0, 0, At, B0); PG8_MMA(0, 1, At, B1); PG8_BAR; PG8_SCHED;
            PG8_LDA(At, 1, 1); PG8_STAGE(PG8_SB(1, 0), b3, voffB); PG8_STAGE(PG8_SB(1, 1), b3 + hstep, voffB); PG8_STAGE(PG8_SA(1, 0), a3, voffA);
            PG8_WAIT_V(8); PG8_WAIT_L(0); PG8_BAR; PG8_MMA(1, 0, At, B0); PG8_MMA(1, 1, At, B1); PG8_BAR; PG8_SCHED;
            } else {
            PG8_LDB(B0, 0, 0); PG8_SCHED; PG8_LDA(At, 0, 0); PG8_STAGE(PG8_SA(1, 1), a1 + hstep, voffA);
            PG8_WAIT_L(8); PG8_BAR; PG8_WAIT_L(0); PG8_MMA(0, 0, At, B0); PG8_BAR; PG8_SCHED;
            PG8_LDB(B1, 0, 1); PG8_STAGE(PG8_SB(0, 0), b2, voffB);
            PG8_BAR; PG8_WAIT_L(0); PG8_MMA(0, 1, At, B1); PG8_BAR;
            PG8_LDA(At, 0, 1); PG8_STAGE(PG8_SA(0, 0), a2, voffA);
            PG8_BAR; PG8_WAIT_L(0); PG8_MMA(1, 0, At, B0); PG8_BAR; PG8_SCHED;
            PG8_STAGE(PG8_SB(0, 1), b2 + hstep, voffB);
            PG8_WAIT_V(6); PG8_BAR; PG8_MMA(1, 1, At, B1); PG8_BAR;
            PG8_LDB(B0, 1, 0); PG8_SCHED; PG8_LDA(At, 1, 0); PG8_STAGE(PG8_SA(0, 1), a2 + hstep, voffA);
            PG8_WAIT_L(8); PG8_BAR; PG8_WAIT_L(0); PG8_MMA(0, 0, At, B0); PG8_BAR; PG8_SCHED;
            PG8_LDB(B1, 1, 1); PG8_STAGE(PG8_SB(1, 0), b3, voffB);
            PG8_BAR; PG8_WAIT_L(0); PG8_MMA(0, 1, At, B1); PG8_BAR;
            PG8_LDA(At, 1, 1); PG8_STAGE(PG8_SA(1, 0), a3, voffA);
            PG8_BAR; PG8_WAIT_L(0); PG8_MMA(1, 0, At, B0); PG8_BAR; PG8_SCHED;
            PG8_STAGE(PG8_SB(1, 1), b3 + hstep, voffB);
            PG8_WAIT_V(6); PG8_BAR; PG8_MMA(1, 1, At, B1); PG8_BAR;
            }
        }
        if constexpr (ALIGN_EPI) { if (wr == 0) PG8_BAR; }
        if constexpr (!Epi::AFTER_DRAIN) { E(acc, cur, wr, wc, fr, fq); S.done(cur); }
        if (!has_next) break;
#pragma unroll
        for (int a = 0; a < 2; ++a)
#pragma unroll
            for (int b = 0; b < 2; ++b)
#pragma unroll
                for (int m = 0; m < 4; ++m)
#pragma unroll
                    for (int n = 0; n < 2; ++n) acc[a][b][m][n] = (f32x4){0.f, 0.f, 0.f, 0.f};
        cur = nxt; cA = nA; cB = nB; ++ui;
        if constexpr (ALIGN_EPI) { if (wr == 1) PG8_BAR; }
    }
    PG8_WAIT_V(0);
    if constexpr (!ALIGN_EPI) { if (wr == 0) PG8_BAR; }
    PG8_BAR;
    if constexpr (Epi::AFTER_DRAIN) { E.fused(acc, cur, wr, wc, fr, fq, lds, wid, lane); S.done(cur); }
#undef PG8_SA
#undef PG8_SB
#undef PG8_STAGE
#undef PG8_LDA
#undef PG8_LDB
#undef PG8_MMA
#undef PG8_WAIT_V
#undef PG8_WAIT_L
#undef PG8_BAR
#undef PG8_SCHED
}
}

#define LAS __attribute__((address_space(3)))
typedef unsigned short bf16_t;
typedef short bf16x8 __attribute__((ext_vector_type(8)));
typedef float f32x4 __attribute__((ext_vector_type(4)));
typedef float f32x16 __attribute__((ext_vector_type(16)));
typedef unsigned u32x4 __attribute__((ext_vector_type(4)));
typedef unsigned u32x2 __attribute__((ext_vector_type(2)));
typedef int i32x4 __attribute__((ext_vector_type(4)));
using pg8::cvtpk; using pg8::pk4; using pg8::rstd_of;

constexpr int NWAVES = 8, NTHREADS = 512;
constexpr int BATCH = 4, SEQ = 8192, DM = 1024, MTOK = BATCH * SEQ, FF = 4096, MEMLEN = 256, MEMROWS = BATCH * MEMLEN;
constexpr float C2 = 0.125f * 1.4426950408889634f;
constexpr size_t MiB = 1u << 20;
constexpr size_t WS_SS = 0;
constexpr size_t WS_KMS = 512 * 1024;
constexpr size_t WS_SS0 = 1 * MiB, WS_SSM = WS_SS0 + 128 * 1024;
constexpr size_t WS_COS = 2 * MiB, WS_SIN = 3 * MiB;
constexpr size_t WS_WA_IN = 4 * MiB, WS_WA_V = 8 * MiB, WS_WA_OUT = 10 * MiB, WS_WA_UP = 12 * MiB, WS_WA_DOWN = 20 * MiB, WS_WB_IN = 28 * MiB, WS_WB_V = 32 * MiB, WS_WB_OUT = 34 * MiB,
                 WS_WB_UP = 36 * MiB, WS_WB_DOWN = 44 * MiB, WS_WA_MEM = 52 * MiB, WS_WB_MEM = 53 * MiB, WS_MEM16 = 54 * MiB,
                 WS_MKA = 56 * MiB, WS_MVA = 56 * MiB + 512 * 1024, WS_MKB = 57 * MiB, WS_MVB = 57 * MiB + 512 * 1024;
constexpr size_t WS_X16 = 64 * MiB, WS_ATT = 128 * MiB, WS_BIG = 192 * MiB, WS_END = 448 * MiB;
constexpr size_t BG_QA = 0, BG_KA = 48 * MiB, BG_VA = 96 * MiB, BG_OA = 144 * MiB, BG_QMA = 240 * MiB;
constexpr size_t BG_QB = 0, BG_KB = 48 * MiB, BG_VB = 96 * MiB, BG_QMB = 144 * MiB, BG_PART = 160 * MiB;
constexpr int PSTR = 68;
constexpr size_t PART_BYTES = (size_t)256 * 4 * PSTR * 4;
static_assert(BG_PART + 256 * PART_BYTES <= 256 * MiB, "partials fit");
constexpr int LDS_BYTES = 147456;

struct WDesc { const float* src; const float* gain; bf16_t* dst; int K, N, col0, ncols, rowoff, perm, start, pad; };
constexpr int NWD = 16;
struct Params {
    const float *x, *mem, *a_lambda, *a_subln, *final_norm;
    float* out; unsigned char* ws;
    WDesc wd[NWD]; int nitems; int pad0;
    float inv[32];
};

__device__ __forceinline__ unsigned f2bf(float f) { unsigned u = __builtin_bit_cast(unsigned, f); return (u + 0x7fffu + ((u >> 16) & 1u)) >> 16; }
__device__ __forceinline__ float bf2f(unsigned h) { return __builtin_bit_cast(float, h << 16); }
__device__ __forceinline__ float wave_sum(float v) {
#pragma unroll
    for (int o = 1; o < 64; o <<= 1) v += __shfl_xor(v, o);
    return v;
}
__device__ __forceinline__ int crow(int r, int hi) { return (r & 3) + 8 * (r >> 2) + 4 * hi; }
#define MFMA32(a, b, c) __builtin_amdgcn_mfma_f32_32x32x16_bf16((a), (b), (c), 0, 0, 0)

__device__ __forceinline__ unsigned long long rfl64(unsigned long long v) { const unsigned lo = __builtin_amdgcn_readfirstlane((unsigned)v), hi = __builtin_amdgcn_readfirstlane((unsigned)(v >> 32)); return ((unsigned long long)hi << 32) | lo; }
__device__ __forceinline__ void p0_transpose_item(const WDesc& w, LAS float* scr, int item, int lane) {
    const int nblk = w.ncols / 32, kb = item / nblk, nb = item % nblk, k0 = 64 * kb, n0 = 32 * nb;
#pragma unroll 8
    for (int i = 0; i < 32; ++i) { const int kk = 2 * i + (lane >> 5); const float g = w.gain ? w.gain[k0 + kk] : 1.f;
        scr[kk * 33 + (lane & 31)] = g * w.src[(size_t)(k0 + kk) * w.N + w.col0 + n0 + (lane & 31)]; }
    asm volatile("s_waitcnt lgkmcnt(0)" ::: "memory");
    const int c = lane & 7;
#pragma unroll
    for (int j = 0; j < 4; ++j) { const int n = (lane >> 3) + 8 * j; const LAS float* s = scr + (8 * c) * 33 + n;
        u32x4 o; o.x = cvtpk(s[0 * 33], s[1 * 33]); o.y = cvtpk(s[2 * 33], s[3 * 33]); o.z = cvtpk(s[4 * 33], s[5 * 33]); o.w = cvtpk(s[6 * 33], s[7 * 33]);
        int nn = n0 + n; if (w.perm) nn = (nn & ~0x30) | ((nn & 0x10) << 1) | ((nn & 0x20) >> 1);
        *(u32x4*)(w.dst + (size_t)(w.rowoff + nn) * w.K + k0 + 8 * c) = o; }
    asm volatile("s_waitcnt lgkmcnt(0)" ::: "memory");
}
__device__ __forceinline__ void row_to_bf16(const float* xrow, bf16_t* orow, float* ssp, int lane) {
    const f32x4* xr = (const f32x4*)xrow + lane; float s = 0.f; f32x4 v[4];
#pragma unroll
    for (int j = 0; j < 4; ++j) { v[j] = xr[64 * j]; s += (v[j][0] * v[j][0] + v[j][1] * v[j][1]) + (v[j][2] * v[j][2] + v[j][3] * v[j][3]); }
    s = wave_sum(s);
    u32x2* o8 = (u32x2*)orow + lane;
#pragma unroll
    for (int j = 0; j < 4; ++j) o8[64 * j] = pk4(v[j]);
    if (lane == 0) *ssp = s;
}
__device__ __forceinline__ void sincos_acc(float a, float& s, float& c) {
    const double x = (double)a, k = __builtin_rint(x * 0.63661977236758134308);
    double r = x - k * 1.57079632679489661923; r -= k * 6.123233995736766e-17;
    const int q = (int)k & 3; const double r2 = r * r;
    const double sp = r * (1.0 + r2 * (-1.0 / 6 + r2 * (1.0 / 120 + r2 * (-1.0 / 5040 + r2 * (1.0 / 362880 + r2 * (-1.0 / 39916800 + r2 * (1.0 / 6227020800.0)))))));
    const double cp = 1.0 + r2 * (-0.5 + r2 * (1.0 / 24 + r2 * (-1.0 / 720 + r2 * (1.0 / 40320 + r2 * (-1.0 / 3628800 + r2 * (1.0 / 479001600 + r2 * (-1.0 / 87178291200.0)))))));
    const double ss = (q == 0) ? sp : (q == 1) ? cp : (q == 2) ? -sp : -cp, cc = (q == 0) ? cp : (q == 1) ? -sp : (q == 2) ? -cp : sp;
    s = (float)ss; c = (float)cc;
}

__device__ __forceinline__ void flash_wave(const bf16x8 (&qf)[4], const bf16_t* Kf, const bf16_t* Vf, int nchunk, int qlim, bool masked, LAS float* sc, int lane,
                                           float& m, float& l, f32x16& o0, f32x16& o1) {
    const int hh = lane >> 5;
    for (int c = 0; c < nchunk; ++c) {
        const bf16_t* kp = Kf + (size_t)c * 4096 + lane * 8; const bf16_t* vp = Vf + (size_t)c * 4096 + lane * 8;
        bf16x8 ka[2][4];
#pragma unroll
        for (int t = 0; t < 2; ++t)
#pragma unroll
            for (int ks = 0; ks < 4; ++ks) ka[t][ks] = *(const bf16x8*)(kp + (t * 4 + ks) * 512);
        f32x16 p0 = {}, p1 = {};
#pragma unroll
        for (int ks = 0; ks < 4; ++ks) { p0 = MFMA32(ka[0][ks], qf[ks], p0); p1 = MFMA32(ka[1][ks], qf[ks], p1); }
        bf16x8 vb[2][2][2];
#pragma unroll
        for (int t = 0; t < 2; ++t)
#pragma unroll
            for (int s = 0; s < 2; ++s)
#pragma unroll
                for (int db = 0; db < 2; ++db) vb[t][s][db] = *(const bf16x8*)(vp + ((t * 2 + s) * 2 + db) * 512);
        if (masked) {
#pragma unroll
            for (int i = 0; i < 16; ++i) { const int key = c * 64 + crow(i, hh); if (key > qlim) p0[i] = -INFINITY; if (key + 32 > qlim) p1[i] = -INFINITY; }
        }
        float rm = fmaxf(p0[0], p1[0]);
#pragma unroll
        for (int i = 1; i < 16; ++i) rm = fmaxf(rm, fmaxf(p0[i], p1[i]));
        rm = fmaxf(rm, __shfl_xor(rm, 32));
        const float mn = fmaxf(m, rm), alpha = __builtin_amdgcn_exp2f(m - mn);
        float sum = 0.f;
#pragma unroll
        for (int i = 0; i < 16; ++i) { p0[i] = __builtin_amdgcn_exp2f(p0[i] - mn); p1[i] = __builtin_amdgcn_exp2f(p1[i] - mn); sum += p0[i] + p1[i]; }
        l = l * alpha + sum; m = mn;
        if (__any(alpha != 1.0f)) {
            sc[lane & 31] = alpha;
#pragma unroll
            for (int g = 0; g < 4; ++g) { const f32x4 a = *(const LAS f32x4*)(sc + 8 * g + 4 * hh);
#pragma unroll
                for (int e = 0; e < 4; ++e) { o0[4 * g + e] *= a[e]; o1[4 * g + e] *= a[e]; } }
        }
#pragma unroll
        for (int s = 0; s < 2; ++s) {
            u32x4 w0, w1;
#pragma unroll
            for (int e = 0; e < 4; ++e) { w0[e] = cvtpk(p0[8 * s + 2 * e], p0[8 * s + 2 * e + 1]); w1[e] = cvtpk(p1[8 * s + 2 * e], p1[8 * s + 2 * e + 1]); }
            const bf16x8 a0 = __builtin_bit_cast(bf16x8, w0), a1 = __builtin_bit_cast(bf16x8, w1);
            o0 = MFMA32(a0, vb[0][s][0], o0); o1 = MFMA32(a0, vb[0][s][1], o1);
            o0 = MFMA32(a1, vb[1][s][0], o0); o1 = MFMA32(a1, vb[1][s][1], o1);
        }
    }
}
__device__ __forceinline__ void mem_attn_phase(const bf16_t* QM, const bf16_t* MK, const bf16_t* MV, bf16_t* att, LAS float* sc, int gw, int ngw, int lane) {
    const int r = lane & 31, hh = lane >> 5;
    for (int it = gw; it < (MTOK / 32) * 4; it += ngw) {
        const int head = it & 3, row0 = (it >> 2) * 32, b = row0 >> 13;
        bf16x8 qf[4];
#pragma unroll
        for (int ks = 0; ks < 4; ++ks) qf[ks] = *(const bf16x8*)(QM + (size_t)(row0 + r) * 256 + head * 64 + ks * 16 + hh * 8);
        float m = -INFINITY, l = 0.f; f32x16 o0 = {}, o1 = {};
        flash_wave(qf, MK + (size_t)(b * 4 + head) * (256 * 64), MV + (size_t)(b * 4 + head) * (256 * 64), 4, 1 << 30, false, sc, lane, m, l, o0, o1);
        l += __shfl_xor(l, 32);
        sc[r] = 1.0f / l;
#pragma unroll
        for (int g = 0; g < 4; ++g) { const f32x4 a = *(const LAS f32x4*)(sc + 8 * g + 4 * hh);
#pragma unroll
            for (int e = 0; e < 4; ++e) { const int i = 4 * g + e; bf16_t* p = att + (size_t)(row0 + crow(i, hh)) * 1024 + 768 + head * 64 + r;
                p[0] = (bf16_t)f2bf(o0[i] * a[e]); p[32] = (bf16_t)f2bf(o1[i] * a[e]); } }
    }
}
constexpr int ML_CNT = 0, ML_IST = 256, ML_LIST = 512, ML_SCR = 512 + 32 * 256 * 2, ML_SCR_STRIDE = 512;
#define TOP3_INSERT(g_, j_) do { const float gg_ = (g_); const int jj_ = (j_); const bool c0_ = gg_ > v0, c1_ = gg_ > v1, c2_ = gg_ > v2; \
    v2 = c1_ ? v1 : (c2_ ? gg_ : v2); i2 = c1_ ? i1 : (c2_ ? jj_ : i2); v1 = c0_ ? v0 : (c1_ ? gg_ : v1); i1 = c0_ ? i0 : (c1_ ? jj_ : i1); v0 = c0_ ? gg_ : v0; i0 = c0_ ? jj_ : i0; } while (0)
__device__ __forceinline__ void moba_phase(const bf16_t* Q, const bf16_t* Kf, const bf16_t* Vf, const float* kms, float* part, bf16_t* att, LAS unsigned char* lds, int tid) {
    const int lane = tid & 63, wave = __builtin_amdgcn_readfirstlane(tid >> 6), r = lane & 31, hh = lane >> 5;
    LAS int* cnt = (LAS int*)(lds + ML_CNT); LAS int* ist = (LAS int*)(lds + ML_IST); LAS unsigned short* list = (LAS unsigned short*)(lds + ML_LIST);
    LAS float* sc = (LAS float*)(lds + ML_SCR + wave * ML_SCR_STRIDE); LAS int* sci = (LAS int*)(sc + 32);
    for (int u = blockIdx.x; u < 48 * 32; u += gridDim.x) {
        const int cur = 31 - u / 48, bh = u % 48, b = bh / 12, h = bh % 12;
        const size_t tok0 = (size_t)b * SEQ + cur * 256;
        const bf16_t* Kbh = Kf + (size_t)bh * (SEQ * 64); const bf16_t* Vbh = Vf + (size_t)bh * (SEQ * 64);
        if (tid < 32) cnt[tid] = 0;
        __syncthreads();
        if (cur > 0) {
            bf16x8 qf[4];
#pragma unroll
            for (int ks = 0; ks < 4; ++ks) qf[ks] = *(const bf16x8*)(Q + (tok0 + wave * 32 + r) * 768 + h * 64 + ks * 16 + hh * 8);
            f32x16 ga = {};
            const float* kr = kms + ((size_t)(bh * 32 + r)) * 64 + hh * 8;
#pragma unroll
            for (int ks = 0; ks < 4; ++ks) { const f32x4 x0 = *(const f32x4*)(kr + ks * 16), x1 = *(const f32x4*)(kr + ks * 16 + 4);
                u32x4 hi, lo;
#pragma unroll
                for (int e = 0; e < 2; ++e) { const float a0 = x0[2 * e], a1 = x0[2 * e + 1], b0 = x1[2 * e], b1 = x1[2 * e + 1];
                    hi[e] = cvtpk(a0, a1); hi[2 + e] = cvtpk(b0, b1);
                    lo[e] = cvtpk(a0 - bf2f(hi[e] & 0xffffu), a1 - bf2f(hi[e] >> 16)); lo[2 + e] = cvtpk(b0 - bf2f(hi[2 + e] & 0xffffu), b1 - bf2f(hi[2 + e] >> 16)); }
                ga = MFMA32(__builtin_bit_cast(bf16x8, hi), qf[ks], ga); ga = MFMA32(__builtin_bit_cast(bf16x8, lo), qf[ks], ga); }
            float v0 = -INFINITY, v1 = -INFINITY, v2 = -INFINITY; int i0 = -1, i1 = -1, i2 = -1;
#pragma unroll
            for (int i = 0; i < 16; ++i) { const int j = crow(i, hh); const float g = (j < cur) ? ga[i] : -INFINITY; TOP3_INSERT(g, j); }
            const float p0 = __shfl_xor(v0, 32), p1 = __shfl_xor(v1, 32), p2 = __shfl_xor(v2, 32); const int q0 = __shfl_xor(i0, 32), q1 = __shfl_xor(i1, 32), q2 = __shfl_xor(i2, 32);
            TOP3_INSERT(p0, q0); TOP3_INSERT(p1, q1); TOP3_INSERT(p2, q2);
            if (hh == 0) { const int qi = wave * 32 + r;
                if (i0 >= 0) { const int p = atomicAdd((int*)&cnt[i0], 1); list[i0 * 256 + p] = (unsigned short)(qi | (0 << 8)); }
                if (i1 >= 0) { const int p = atomicAdd((int*)&cnt[i1], 1); list[i1 * 256 + p] = (unsigned short)(qi | (1 << 8)); }
                if (i2 >= 0) { const int p = atomicAdd((int*)&cnt[i2], 1); list[i2 * 256 + p] = (unsigned short)(qi | (2 << 8)); } }
        }
        __syncthreads();
        if (tid == 0) { int a = 0; for (int j = 0; j < 32; ++j) { ist[j] = a; a += (j < cur) ? ((cnt[j] + 31) >> 5) : 0; } ist[32] = a; }
        __syncthreads();
        const int nsel = ist[32];
        for (int x = wave; x < nsel + 8; x += NWAVES) {
            int j, qi, slot, nchunk, qlim; bool valid, masked;
            if (x < nsel) { j = 0; while (ist[j + 1] <= x) ++j; const int g = x - ist[j], n = cnt[j], p = g * 32 + r; valid = p < n;
                const int e = list[j * 256 + (valid ? p : n - 1)]; qi = e & 255; slot = e >> 8; nchunk = 4; qlim = 1 << 30; masked = false; }
            else { const int g = x - nsel; j = cur; qi = g * 32 + r; slot = 3; valid = true; nchunk = (g >> 1) + 1; qlim = qi; masked = true; }
            bf16x8 qf[4];
#pragma unroll
            for (int ks = 0; ks < 4; ++ks) qf[ks] = *(const bf16x8*)(Q + (tok0 + qi) * 768 + h * 64 + ks * 16 + hh * 8);
            float m = -INFINITY, l = 0.f; f32x16 o0 = {}, o1 = {};
            flash_wave(qf, Kbh + (size_t)j * (256 * 64), Vbh + (size_t)j * (256 * 64), nchunk, qlim, masked, sc, lane, m, l, o0, o1);
            l += __shfl_xor(l, 32);
            sci[r] = valid ? (qi * 4 + slot) : -1;
#pragma unroll
            for (int g = 0; g < 4; ++g) { const i32x4 rid = *(const LAS i32x4*)(sci + 8 * g + 4 * hh);
#pragma unroll
                for (int e = 0; e < 4; ++e) if (rid[e] >= 0) { float* p = part + (size_t)rid[e] * PSTR + r; p[0] = o0[4 * g + e]; p[32] = o1[4 * g + e]; } }
            if (valid && hh == 0) { float* p = part + (size_t)(qi * 4 + slot) * PSTR + 64; p[0] = m; p[1] = l; }
        }
        __threadfence();
        __syncthreads();
        __builtin_amdgcn_fence(__ATOMIC_ACQUIRE, "agent");
        { const int qi = tid >> 1, dh = tid & 1, nv = cur < 3 ? cur : 3;
            const float* pq = part + (size_t)(qi * 4) * PSTR;
            float mk[4], lk[4]; float M = pq[3 * PSTR + 64]; mk[3] = M; lk[3] = pq[3 * PSTR + 65];
#pragma unroll
            for (int k = 0; k < 3; ++k) { if (k < nv) { mk[k] = pq[k * PSTR + 64]; lk[k] = pq[k * PSTR + 65]; M = fmaxf(M, mk[k]); } else { mk[k] = -INFINITY; lk[k] = 0.f; } }
            float wk[4], L = 0.f;
#pragma unroll
            for (int k = 0; k < 4; ++k) { wk[k] = (k == 3 || k < nv) ? __builtin_amdgcn_exp2f(mk[k] - M) : 0.f; L += wk[k] * lk[k]; }
            const float invL = 1.0f / L;
            bf16_t* op = att + (tok0 + qi) * 1024 + h * 64 + dh * 32;
#pragma unroll
            for (int c = 0; c < 4; ++c) { f32x4 a0 = {0.f, 0.f, 0.f, 0.f}, a1 = {0.f, 0.f, 0.f, 0.f};
#pragma unroll
                for (int k = 0; k < 4; ++k) if (k == 3 || k < nv) { const f32x4* s = (const f32x4*)(pq + k * PSTR + dh * 32 + c * 8); a0 += s[0] * wk[k]; a1 += s[1] * wk[k]; }
                a0 = a0 * invL; a1 = a1 * invL;
                u32x4 o; o.x = cvtpk(a0[0], a0[1]); o.y = cvtpk(a0[2], a0[3]); o.z = cvtpk(a1[0], a1[1]); o.w = cvtpk(a1[2], a1[3]);
                *(u32x4*)(op + c * 8) = o; }
        }
        __syncthreads();
    }
}
__device__ __forceinline__ void diff_combine_phase(const bf16_t* O, const float* lamp, const float* subln, bf16_t* att, int gw, int ngw, int lane) {
    const float s01 = wave_sum(lamp[lane] * lamp[64 + lane]), s23 = wave_sum(lamp[128 + lane] * lamp[192 + lane]);
    const float lam_init = 0.2f, lam = expf(s01) - expf(s23) + lam_init;
    const int sub = lane >> 4, e16 = lane & 15;
    const f32x4 g0 = *(const f32x4*)(subln + e16 * 8), g1 = *(const f32x4*)(subln + e16 * 8 + 4);
    for (int it = gw; it < MTOK * 6 / 4; it += ngw) {
        const int pr = it * 4 + sub, row = pr / 6, hd = pr % 6;
        const bf16_t* p1 = O + (size_t)row * 1536 + hd * 256 + e16 * 8;
        const u32x4 a = *(const u32x4*)p1, c = *(const u32x4*)(p1 + 128);
        float o[8]; float q = 0.f;
#pragma unroll
        for (int e = 0; e < 4; ++e) { o[2 * e] = bf2f(a[e] & 0xffffu) - lam * bf2f(c[e] & 0xffffu); o[2 * e + 1] = bf2f(a[e] >> 16) - lam * bf2f(c[e] >> 16); q += o[2 * e] * o[2 * e] + o[2 * e + 1] * o[2 * e + 1]; }
#pragma unroll
        for (int s = 1; s < 16; s <<= 1) q += __shfl_xor(q, s);
        const float rs = (1.0f / sqrtf(q * (1.0f / 128.0f) + 1e-6f)) * (1.0f - lam_init);
        u32x4 w; w.x = cvtpk(o[0] * rs * g0[0], o[1] * rs * g0[1]); w.y = cvtpk(o[2] * rs * g0[2], o[3] * rs * g0[3]); w.z = cvtpk(o[4] * rs * g1[0], o[5] * rs * g1[1]); w.w = cvtpk(o[6] * rs * g1[2], o[7] * rs * g1[3]);
        *(u32x4*)(att + (size_t)row * 1024 + hd * 128 + e16 * 8) = w;
    }
}
constexpr int DA_KB = 8192, DA_VB = 16384, DA_BUF = DA_KB + DA_VB;
__device__ __forceinline__ void diff_attn_phase(const bf16_t* Q, const bf16_t* Kf, const bf16_t* Vf, bf16_t* O, LAS unsigned char* lds, int tid) {
    const int lane = tid & 63, wave = __builtin_amdgcn_readfirstlane(tid >> 6), r = lane & 31, hh = lane >> 5;
    LAS float* sc = (LAS float*)(lds + 2 * DA_BUF + wave * 512);
    const int G = gridDim.x, bx = blockIdx.x, vcu = (G % 8 == 0) ? (bx % 8) * (G / 8) + bx / 8 : bx;
    for (int pi = vcu; pi < 768; pi += G) {
        const int bvh = pi >> 4, s16 = pi & 15, b = bvh / 12, vh = bvh % 12;
        const bf16_t* Kseq = Kf + (size_t)(b * 12 + vh) * (SEQ * 64); const bf16_t* Vseq = Vf + (size_t)(b * 6 + (vh >> 1)) * (SEQ * 128);
        for (int half = 0; half < 2; ++half) {
            const int qb = half ? 31 - s16 : s16, nc = 4 * (qb + 1);
            const size_t tok0 = (size_t)b * SEQ + qb * 256 + wave * 32;
            bf16x8 qf[4];
#pragma unroll
            for (int ks = 0; ks < 4; ++ks) qf[ks] = *(const bf16x8*)(Q + (tok0 + r) * 768 + vh * 64 + ks * 16 + hh * 8);
            const bf16_t* src0 = Kseq + tid * 8;
            const bf16_t* src1 = Vseq + tid * 8; const bf16_t* src2 = src1 + 4096;
            u32x4 g0 = *(const u32x4*)src0, g1 = *(const u32x4*)src1, g2 = *(const u32x4*)src2;
            { LAS unsigned char* d = lds + tid * 16; *(LAS u32x4*)d = g0; *(LAS u32x4*)(d + DA_KB) = g1; *(LAS u32x4*)(d + DA_KB + 8192) = g2; }
            __syncthreads();
            float m = -INFINITY, l = 0.f; f32x16 o0 = {}, o1 = {}, o2 = {}, o3 = {};
            const int qlim = wave * 32 + r;
            for (int c = 0; c < nc; ++c) {
                const bool more = c + 1 < nc;
                if (more) { g0 = *(const u32x4*)(src0 + (size_t)(c + 1) * 4096); g1 = *(const u32x4*)(src1 + (size_t)(c + 1) * 8192); g2 = *(const u32x4*)(src2 + (size_t)(c + 1) * 8192); }
                const int cd = c - (nc - 4);
                if (!(cd >= 0 && cd * 64 > wave * 32 + 31)) {
                    const LAS unsigned char* kb = lds + (c & 1) * DA_BUF + lane * 16; const LAS unsigned char* vbp = kb + DA_KB;
                    f32x16 p0 = {}, p1 = {};
#pragma unroll
                    for (int ks = 0; ks < 4; ++ks) { const bf16x8 k0 = *(const LAS bf16x8*)(kb + ks * 1024), k1 = *(const LAS bf16x8*)(kb + (4 + ks) * 1024);
                        p0 = MFMA32(k0, qf[ks], p0); p1 = MFMA32(k1, qf[ks], p1); }
                    if (cd >= 0) {
#pragma unroll
                        for (int i = 0; i < 16; ++i) { const int key = cd * 64 + crow(i, hh); if (key > qlim) p0[i] = -INFINITY; if (key + 32 > qlim) p1[i] = -INFINITY; }
                    }
                    float rm = fmaxf(p0[0], p1[0]);
#pragma unroll
                    for (int i = 1; i < 16; ++i) rm = fmaxf(rm, fmaxf(p0[i], p1[i]));
                    rm = fmaxf(rm, __shfl_xor(rm, 32));
                    const float mn = fmaxf(m, rm), alpha = __builtin_amdgcn_exp2f(m - mn);
                    float sum = 0.f;
#pragma unroll
                    for (int i = 0; i < 16; ++i) { p0[i] = __builtin_amdgcn_exp2f(p0[i] - mn); p1[i] = __builtin_amdgcn_exp2f(p1[i] - mn); sum += p0[i] + p1[i]; }
                    l = l * alpha + sum; m = mn;
                    if (__any(alpha != 1.0f)) {
                        sc[r] = alpha;
#pragma unroll
                        for (int g = 0; g < 4; ++g) { const f32x4 a = *(const LAS f32x4*)(sc + 8 * g + 4 * hh);
#pragma unroll
                            for (int e = 0; e < 4; ++e) { o0[4 * g + e] *= a[e]; o1[4 * g + e] *= a[e]; o2[4 * g + e] *= a[e]; o3[4 * g + e] *= a[e]; } }
                    }
#pragma unroll
                    for (int t = 0; t < 2; ++t)
#pragma unroll
                        for (int s = 0; s < 2; ++s) {
                            u32x4 w;
#pragma unroll
                            for (int e = 0; e < 4; ++e) w[e] = t ? cvtpk(p1[8 * s + 2 * e], p1[8 * s + 2 * e + 1]) : cvtpk(p0[8 * s + 2 * e], p0[8 * s + 2 * e + 1]);
                            const bf16x8 pa = __builtin_bit_cast(bf16x8, w);
                            const LAS unsigned char* vq = vbp + ((t * 2 + s) * 4) * 1024;
                            o0 = MFMA32(pa, *(const LAS bf16x8*)(vq), o0); o1 = MFMA32(pa, *(const LAS bf16x8*)(vq + 1024), o1);
                            o2 = MFMA32(pa, *(const LAS bf16x8*)(vq + 2048), o2); o3 = MFMA32(pa, *(const LAS bf16x8*)(vq + 3072), o3);
                        }
                }
                if (more) { LAS unsigned char* d = lds + ((c + 1) & 1) * DA_BUF + tid * 16; *(LAS u32x4*)d = g0; *(LAS u32x4*)(d + DA_KB) = g1; *(LAS u32x4*)(d + DA_KB + 8192) = g2; }
                __syncthreads();
            }
            l += __shfl_xor(l, 32);
            sc[r] = 1.0f / l;
#pragma unroll
            for (int g = 0; g < 4; ++g) { const f32x4 a = *(const LAS f32x4*)(sc + 8 * g + 4 * hh);
#pragma unroll
                for (int e = 0; e < 4; ++e) { const int i = 4 * g + e; bf16_t* p = O + (tok0 + crow(i, hh)) * 1536 + vh * 128 + r;
                    p[0] = (bf16_t)f2bf(o0[i] * a[e]); p[32] = (bf16_t)f2bf(o1[i] * a[e]); p[64] = (bf16_t)f2bf(o2[i] * a[e]); p[96] = (bf16_t)f2bf(o3[i] * a[e]); } }
        }
    }
}
__global__ void __launch_bounds__(NTHREADS, 2) fwd_kernel(Params P) {
    extern __shared__ __attribute__((aligned(16))) unsigned char lds[];
    cg::grid_group grid = cg::this_grid();
    LAS unsigned char* L = (LAS unsigned char*)lds;
#define PHASE_PTRS \
    int tid = threadIdx.x; asm volatile("" : "+v"(tid)); const int lane = tid & 63, wave = __builtin_amdgcn_readfirstlane(tid >> 6); \
    const int G = gridDim.x, bx = blockIdx.x, gw = bx * NWAVES + wave, ngw = G * NWAVES, gtid = bx * NTHREADS + tid, nthr = G * NTHREADS; \
    (void)lane; (void)gw; (void)ngw; (void)gtid; (void)nthr; \
    unsigned char* ws; { unsigned char* t_ = P.ws; asm volatile("" : "=s"(ws) : "0"(t_)); } \
    float* ss1 = (float*)(ws + WS_SS); float* ss2 = ss1 + MTOK; float* ss3 = ss2 + MTOK; float* ss4 = ss3 + MTOK; (void)ss1; (void)ss2; (void)ss3; (void)ss4; \
    float* kms = (float*)(ws + WS_KMS); float* ss0 = (float*)(ws + WS_SS0); float* ssm = (float*)(ws + WS_SSM); (void)kms; (void)ss0; (void)ssm; \
    float* cosT = (float*)(ws + WS_COS); float* sinT = (float*)(ws + WS_SIN); (void)cosT; (void)sinT; \
    bf16_t* WA_in = (bf16_t*)(ws + WS_WA_IN); bf16_t* WA_v = (bf16_t*)(ws + WS_WA_V); (void)WA_v; bf16_t* WA_out = (bf16_t*)(ws + WS_WA_OUT); bf16_t* WA_up = (bf16_t*)(ws + WS_WA_UP); bf16_t* WA_down = (bf16_t*)(ws + WS_WA_DOWN); \
    bf16_t* WB_in = (bf16_t*)(ws + WS_WB_IN); bf16_t* WB_v = (bf16_t*)(ws + WS_WB_V); bf16_t* WB_out = (bf16_t*)(ws + WS_WB_OUT); bf16_t* WB_up = (bf16_t*)(ws + WS_WB_UP); bf16_t* WB_down = (bf16_t*)(ws + WS_WB_DOWN); \
    bf16_t* WA_mem = (bf16_t*)(ws + WS_WA_MEM); bf16_t* WB_mem = (bf16_t*)(ws + WS_WB_MEM); bf16_t* mem16 = (bf16_t*)(ws + WS_MEM16); \
    bf16_t* MKA = (bf16_t*)(ws + WS_MKA); bf16_t* MVA = (bf16_t*)(ws + WS_MVA); bf16_t* MKB = (bf16_t*)(ws + WS_MKB); bf16_t* MVB = (bf16_t*)(ws + WS_MVB); \
    bf16_t* x16 = (bf16_t*)(ws + WS_X16); bf16_t* att = (bf16_t*)(ws + WS_ATT); unsigned char* big = ws + WS_BIG; \
    bf16_t* QA = (bf16_t*)(big + BG_QA); bf16_t* KA = (bf16_t*)(big + BG_KA); bf16_t* VA = (bf16_t*)(big + BG_VA); bf16_t* OA = (bf16_t*)(big + BG_OA); bf16_t* QMA = (bf16_t*)(big + BG_QMA); \
    bf16_t* QB = (bf16_t*)(big + BG_QB); bf16_t* KBf = (bf16_t*)(big + BG_KB); bf16_t* VBf = (bf16_t*)(big + BG_VB); bf16_t* QMB = (bf16_t*)(big + BG_QMB); bf16_t* H = (bf16_t*)big; \
    (void)WA_in; (void)WA_out; (void)WA_up; (void)WA_down; (void)WB_in; (void)WB_v; (void)WB_out; (void)WB_up; (void)WB_down; (void)WA_mem; (void)WB_mem; (void)mem16; (void)MKA; (void)MVA; (void)MKB; (void)MVB; \
    (void)x16; (void)att; (void)QA; (void)KA; (void)VA; (void)OA; (void)QMA; (void)QB; (void)KBf; (void)VBf; (void)QMB; (void)H; \
    LAS float* wsc = (LAS float*)(L + wave * 512); (void)wsc;

    { PHASE_PTRS
        for (int i = gtid; i < 57344; i += nthr) ((u32x4*)ws)[i] = (u32x4){0u, 0u, 0u, 0u};
        { float myinv = 0.f;
#pragma unroll
            for (int d = 0; d < 32; ++d) myinv = ((lane & 31) == d) ? P.inv[d] : myinv;
            for (int e = gtid; e < SEQ * 32; e += nthr) { float s, c; sincos_acc((float)(e >> 5) * myinv, s, c); cosT[e] = c; sinT[e] = s; } }
        for (int m = gw; m < MTOK; m += ngw) row_to_bf16(P.x + (size_t)m * DM, x16 + (size_t)m * DM, ss0 + m, lane);
        for (int m = gw; m < MEMROWS; m += ngw) row_to_bf16(P.mem + (size_t)m * DM, mem16 + (size_t)m * DM, ssm + m, lane);
        LAS float* scr = (LAS float*)(L + wave * 16384);
        LAS unsigned long long* T = (LAS unsigned long long*)(L + 132096);
#pragma unroll
        for (int k = 0; k < NWD; ++k) if (tid == k) { T[k * 8 + 0] = (unsigned long long)P.wd[k].src; T[k * 8 + 1] = (unsigned long long)P.wd[k].gain; T[k * 8 + 2] = (unsigned long long)P.wd[k].dst;
            T[k * 8 + 3] = (unsigned)P.wd[k].K | ((unsigned long long)(unsigned)P.wd[k].N << 32); T[k * 8 + 4] = (unsigned)P.wd[k].col0 | ((unsigned long long)(unsigned)P.wd[k].ncols << 32);
            T[k * 8 + 5] = (unsigned)P.wd[k].rowoff | ((unsigned long long)(unsigned)P.wd[k].perm << 32); T[k * 8 + 6] = (unsigned)P.wd[k].start; }
        __syncthreads();
        const int nitems = P.nitems;
        for (int it = gw; it < nitems; it += ngw) {
            int k = 0;
            for (int j = 1; j < NWD; ++j) if (it >= (int)(unsigned)T[j * 8 + 6]) k = j;
            k = __builtin_amdgcn_readfirstlane(k);
            WDesc w; w.src = (const float*)rfl64(T[k * 8 + 0]); w.gain = (const float*)rfl64(T[k * 8 + 1]); w.dst = (bf16_t*)rfl64(T[k * 8 + 2]);
            { const unsigned long long a = rfl64(T[k * 8 + 3]), b = rfl64(T[k * 8 + 4]), c = rfl64(T[k * 8 + 5]), d = rfl64(T[k * 8 + 6]);
              w.K = (int)(unsigned)a; w.N = (int)(a >> 32); w.col0 = (int)(unsigned)b; w.ncols = (int)(b >> 32); w.rowoff = (int)(unsigned)c; w.perm = (int)(c >> 32); w.start = (int)(unsigned)d; w.pad = 0; }
            p0_transpose_item(w, scr, it - w.start, lane);
        }
        __syncthreads();
    }
    grid.sync();
    { PHASE_PTRS
        { pg8::Gemm g{x16, WA_in, MTOK, 1792, DM}; pg8::StaticOrder S; S.init(MTOK, 1792, G, bx);
          pg8::EpiInB E{KA, QA, QMA, nullptr, ss0, cosT, sinT, C2}; pg8::gemm_phase<pg8::EpiInB, pg8::StaticOrder, true, true>(L, g, S, E); }
        { pg8::Gemm g{WA_v, x16, 768, MTOK, DM}; pg8::StaticOrder S; S.init(768, MTOK, G, (bx + G / 2) % G);
          pg8::EpiVt<13, 6, 7> E{VA, ss0}; pg8::gemm_phase<pg8::EpiVt<13, 6, 7>, pg8::StaticOrder, true, true>(L, g, S, E); }
        { pg8::Gemm g{mem16, WA_mem, MEMROWS, 256, DM}; pg8::StaticOrder S; S.init(MEMROWS, 256, G, bx);
          pg8::EpiMemK E{MKA, ssm}; pg8::gemm_phase<pg8::EpiMemK, pg8::StaticOrder, true, true>(L, g, S, E); }
        { pg8::Gemm g{mem16, WB_mem, MEMROWS, 256, DM}; pg8::StaticOrder S; S.init(MEMROWS, 256, G, (bx + G - 4) % G);
          pg8::EpiMemK E{MKB, ssm}; pg8::gemm_phase<pg8::EpiMemK, pg8::StaticOrder, true, true>(L, g, S, E); }
        { pg8::Gemm g{WA_mem + 256 * DM, mem16, 256, MEMROWS, DM}; pg8::StaticOrder S; S.init(256, MEMROWS, G, (bx + G - 8) % G);
          pg8::EpiVt<8, 4, 6> E{MVA, ssm}; pg8::gemm_phase<pg8::EpiVt<8, 4, 6>, pg8::StaticOrder, true, true>(L, g, S, E); }
        { pg8::Gemm g{WB_mem + 256 * DM, mem16, 256, MEMROWS, DM}; pg8::StaticOrder S; S.init(256, MEMROWS, G, (bx + G - 12) % G);
          pg8::EpiVt<8, 4, 6> E{MVB, ssm}; pg8::gemm_phase<pg8::EpiVt<8, 4, 6>, pg8::StaticOrder, true, true>(L, g, S, E); }
    }
    grid.sync();
    { PHASE_PTRS
        mem_attn_phase(QMA, MKA, MVA, att, wsc, gw, ngw, lane);
        __syncthreads();
        diff_attn_phase(QA, KA, VA, OA, L, tid);
    }
    grid.sync();
    { PHASE_PTRS diff_combine_phase(OA, P.a_lambda, P.a_subln, att, gw, ngw, lane); }
    grid.sync();
    { PHASE_PTRS pg8::Gemm g{att, WA_out, MTOK, DM, DM}; pg8::StaticOrder S; S.init(MTOK, DM, G, bx);
      pg8::EpiRes E{P.x, P.out, x16, ss1}; pg8::gemm_phase<pg8::EpiRes, pg8::StaticOrder, true, true>(L, g, S, E); }
    grid.sync();
    { PHASE_PTRS pg8::Gemm g{x16, WA_up, MTOK, FF, DM}; pg8::StaticOrder S; S.init(MTOK, FF, G, bx);
      pg8::EpiUp E{H, ss1}; pg8::gemm_phase<pg8::EpiUp, pg8::StaticOrder, true, true>(L, g, S, E); }
    grid.sync();
    { PHASE_PTRS pg8::Gemm g{H, WA_down, MTOK, DM, FF}; pg8::StaticOrder S; S.init(MTOK, DM, G, bx);
      pg8::EpiRes E{P.out, P.out, x16, ss2}; pg8::gemm_phase<pg8::EpiRes, pg8::StaticOrder, true, true>(L, g, S, E); }
    grid.sync();
    { PHASE_PTRS
        { pg8::Gemm g{x16, WB_in, MTOK, 1792, DM}; pg8::StaticOrder S; S.init(MTOK, 1792, G, bx);
          pg8::EpiInB E{KBf, QB, QMB, kms, ss2, cosT, sinT, C2}; pg8::gemm_phase<pg8::EpiInB, pg8::StaticOrder, true, true>(L, g, S, E); }
        { pg8::Gemm g{WB_v, x16, 768, MTOK, DM}; pg8::StaticOrder S; S.init(768, MTOK, G, (bx + G / 2) % G);
          pg8::EpiVt<13, 12, 6> E{VBf, ss2}; pg8::gemm_phase<pg8::EpiVt<13, 12, 6>, pg8::StaticOrder, true, true>(L, g, S, E); }
    }
    grid.sync();
    { PHASE_PTRS
        float* part = (float*)(big + BG_PART + (size_t)bx * PART_BYTES);
        mem_attn_phase(QMB, MKB, MVB, att, wsc, gw, ngw, lane);
        __syncthreads();
        moba_phase(QB, KBf, VBf, kms, part, att, L, tid);
    }
    grid.sync();
    { PHASE_PTRS pg8::Gemm g{att, WB_out, MTOK, DM, DM}; pg8::StaticOrder S; S.init(MTOK, DM, G, bx);
      pg8::EpiRes E{P.out, P.out, x16, ss3}; pg8::gemm_phase<pg8::EpiRes, pg8::StaticOrder, true, true>(L, g, S, E); }
    grid.sync();
    { PHASE_PTRS pg8::Gemm g{x16, WB_up, MTOK, FF, DM}; pg8::StaticOrder S; S.init(MTOK, FF, G, bx);
      pg8::EpiUp E{H, ss3}; pg8::gemm_phase<pg8::EpiUp, pg8::StaticOrder, true, true>(L, g, S, E); }
    grid.sync();
    { PHASE_PTRS pg8::Gemm g{H, WB_down, MTOK, DM, FF}; pg8::StaticOrder S; S.init(MTOK, DM, G, bx);
      pg8::EpiRes E{P.out, P.out, x16, ss4}; pg8::gemm_phase<pg8::EpiRes, pg8::StaticOrder, true, true>(L, g, S, E); }
    grid.sync();
    { PHASE_PTRS
    for (int m = gw; m < MTOK; m += ngw) {
        const float rs = rstd_of(ss4[m]); f32x4* xr = (f32x4*)(P.out + (size_t)m * DM) + lane; const f32x4* gr = (const f32x4*)P.final_norm + lane;
#pragma unroll
        for (int j = 0; j < 4; ++j) xr[64 * j] = xr[64 * j] * rs * gr[64 * j];
    } }
}

extern "C" void kernel_launch(void* const* d_in, const int* in_sizes, int n_in, void* d_out, int out_size, void* d_ws, size_t ws_size, hipStream_t stream) {
    static int ready = 0;
    if (ready == 0) {
        ready = -1;
        if (n_in != 23 || in_sizes[0] != MTOK * DM || out_size != MTOK * DM || ws_size < WS_END) { fprintf(stderr, "kernel_launch: unexpected shapes / workspace (n_in %d, ws %zu)\n", n_in, ws_size); return; }
        if (hipFuncSetAttribute((const void*)fwd_kernel, hipFuncAttributeMaxDynamicSharedMemorySize, LDS_BYTES) != hipSuccess) { fprintf(stderr, "kernel_launch: hipFuncSetAttribute failed\n"); return; }
        ready = 1;
    }
    if (ready < 0) return;
    Params p{};
    p.x = (const float*)d_in[0]; p.mem = (const float*)d_in[1]; p.a_lambda = (const float*)d_in[4]; p.a_subln = (const float*)d_in[5]; p.final_norm = (const float*)d_in[22];
    p.out = (float*)d_out; p.ws = (unsigned char*)d_ws;
    unsigned char* ws = (unsigned char*)d_ws;
    auto F = [&](int i) { return (const float*)d_in[i]; };
    auto B = [&](size_t off) { return (bf16_t*)(ws + off); };
    const WDesc wd[NWD] = {
        {F(3),  F(2),  B(WS_WA_IN),   1024, 2560, 768,  768,  0,    1, 0, 0},
        {F(3),  F(2),  B(WS_WA_IN),   1024, 2560, 0,    768,  768,  1, 0, 0},
        {F(3),  F(2),  B(WS_WA_IN),   1024, 2560, 2304, 256,  1536, 0, 0, 0},
        {F(3),  F(2),  B(WS_WA_V),    1024, 2560, 1536, 768,  0,    0, 0, 0},
        {F(7),  F(6),  B(WS_WA_MEM),  1024, 512,  0,    512,  0,    0, 0, 0},
        {F(8),  nullptr, B(WS_WA_OUT), 1024, 1024, 0,   1024, 0,    0, 0, 0},
        {F(10), F(9),  B(WS_WA_UP),   1024, 4096, 0,    4096, 0,    0, 0, 0},
        {F(11), nullptr, B(WS_WA_DOWN), 4096, 1024, 0,  1024, 0,    0, 0, 0},
        {F(13), F(12), B(WS_WB_IN),   1024, 1536, 0,    768,  0,    1, 0, 0},
        {F(13), F(12), B(WS_WB_V),    1024, 1536, 768,  768,  0,    0, 0, 0},
        {F(15), F(14), B(WS_WB_IN),   1024, 1024, 0,    768,  768,  1, 0, 0},
        {F(15), F(14), B(WS_WB_IN),   1024, 1024, 768,  256,  1536, 0, 0, 0},
        {F(17), F(16), B(WS_WB_MEM),  1024, 512,  0,    512,  0,    0, 0, 0},
        {F(18), nullptr, B(WS_WB_OUT), 1024, 1024, 0,   1024, 0,    0, 0, 0},
        {F(20), F(19), B(WS_WB_UP),   1024, 4096, 0,    4096, 0,    0, 0, 0},
        {F(21), nullptr, B(WS_WB_DOWN), 4096, 1024, 0,  1024, 0,    0, 0, 0},
    };
    int start = 0;
    for (int k = 0; k < NWD; ++k) { p.wd[k] = wd[k]; p.wd[k].start = start; start += (wd[k].K / 64) * (wd[k].ncols / 32); }
    p.nitems = start;
    for (int d = 0; d < 32; ++d) p.inv[d] = 1.0f / powf(10000.0f, (float)d / 32.0f);
    void* args[] = {&p};
    const hipError_t e = hipLaunchCooperativeKernel((const void*)fwd_kernel, dim3(256), dim3(NTHREADS), args, LDS_BYTES, stream);
    if (e != hipSuccess) fprintf(stderr, "kernel_launch: cooperative launch failed: %s\n", hipGetErrorString(e));
}
```

```cpp
#include <hip/hip_runtime.h>
#include <hip/hip_cooperative_groups.h>
#include <cmath>
namespace cg = cooperative_groups;
#include <hip/hip_runtime.h>
#include <cstdio>
#include <cstdint>
namespace pg8 {
#define PG8_LAS __attribute__((address_space(3)))
typedef unsigned short bf16_t;
typedef short bf16x8 __attribute__((ext_vector_type(8)));
typedef float f32x4 __attribute__((ext_vector_type(4)));
typedef unsigned u32x4 __attribute__((ext_vector_type(4)));
constexpr int BM = 256, BK = 64, HALF = 128, HTB = HALF * BK * 2  , STAGE_BYTES = 8 * HTB, NXCD = 8, WGM = 8;

__host__ __device__ __forceinline__ int lds_byte(int r, int c) { const int st = (r >> 4) * 2 + (c >> 5), rr = r & 15, cc = c & 31, ob = rr * 64 + cc * 2; return st * 1024 + (ob ^ (((ob >> 9) & 1) << 5)); }
__host__ __device__ __forceinline__ void stage_rc(int b, int& R, int& C) { const int st = b / 1024, sb = b % 1024, swz = sb ^ (((sb >> 9) & 1) << 5); R = (st >> 1) * 16 + swz / 64; C = (st & 1) * 32 + (swz % 64) / 2; }
__host__ __device__ __forceinline__ int perm32(int rho) { const int n = rho >> 4, i = rho & 15; return 8 * (i >> 2) + 4 * n + (i & 3); }

struct Unit { int pm, pn; };
struct Gemm { const bf16_t* A; const bf16_t* Bt; int M, N, K; };

struct StaticOrder {
    int nM, nN, nwg, G, c;
    __host__ __device__ void init(int M, int N, int G_, int c_) { nM = M / BM; nN = N / BM; nwg = nM * nN; G = G_; c = c_; }
    __host__ __device__ bool next(int i, Unit& u) const {
        const long L = (long)i * G + c; if (L >= nwg) return false;
        int wgid = (int)L; { const int q = nwg / NXCD, r = nwg % NXCD, xcd = wgid % NXCD, off = wgid / NXCD; wgid = (xcd < r ? xcd * (q + 1) : r * (q + 1) + (xcd - r) * q) + off; }
        const int nig = WGM * nN, gid = wgid / nig, fm = gid * WGM, gsz = (nM - fm) < WGM ? (nM - fm) : WGM;
        u.pm = fm + ((wgid % nig) % gsz); u.pn = (wgid % nig) / gsz; return true;
    }
    __device__ __forceinline__ void a_ready(const Unit&) const {}
    __device__ __forceinline__ void done(const Unit&) const {}
};

typedef float f32x2_t __attribute__((ext_vector_type(2))); typedef __bf16 bf16x2_t __attribute__((ext_vector_type(2)));
typedef unsigned u32x2 __attribute__((ext_vector_type(2)));
__device__ __forceinline__ unsigned cvtpk(float lo, float hi) { f32x2_t v = {lo, hi}; bf16x2_t b = __builtin_convertvector(v, bf16x2_t); return __builtin_bit_cast(unsigned, b); }
__device__ __forceinline__ u32x2 pk4(const f32x4 v) { u32x2 w; w.x = cvtpk(v[0], v[1]); w.y = cvtpk(v[2], v[3]); return w; }
constexpr float RMS_EPS = 1e-6f;
__device__ __forceinline__ float rstd_of(float ss) { return 1.0f / sqrtf(ss * (1.0f / 1024.0f) + RMS_EPS); }

struct EpiInB {
    static constexpr bool PERM = false, AFTER_DRAIN = false;
    bf16_t *Kf, *Q, *QM; float* kms; const float* ss; const float* cs; const float* sn; float c2;
    __device__ __forceinline__ void operator()(const f32x4 (&acc)[2][2][4][2], const Unit& u, int wr, int wc, int fr, int fq) const {
        const int tile = u.pn, row0 = u.pm * BM + wr * 64 + fr;
        if (tile < 6) {
            const bool isk = tile < 3; const float sc = isk ? 1.f : c2; const int d1 = (wc & 1) * 16 + fq * 4;
            f32x4 cs1[2] = {{0.f, 0.f, 0.f, 0.f}, {0.f, 0.f, 0.f, 0.f}}, cs2[2] = {{0.f, 0.f, 0.f, 0.f}, {0.f, 0.f, 0.f, 0.f}};
#pragma unroll
            for (int ai = 0; ai < 2; ++ai)
#pragma unroll
                for (int m = 0; m < 4; ++m) { const int row = row0 + ai * HALF + m * 16, pos = row & 8191, b = row >> 13; const float rs = rstd_of(ss[row]) * sc;
                    const f32x4 c4 = *(const f32x4*)(cs + pos * 32 + d1), s4 = *(const f32x4*)(sn + pos * 32 + d1);
#pragma unroll
                    for (int bj = 0; bj < 2; ++bj) { const f32x4 x1 = acc[ai][bj][m][0] * rs, x2 = acc[ai][bj][m][1] * rs;
                        const f32x4 o1 = x1 * c4 - x2 * s4, o2 = x2 * c4 + x1 * s4;
                        const int hl = bj * 2 + (wc >> 1);
                        if (isk) { const int h = tile * 4 + hl; if (kms) { cs1[bj] += o1; cs2[bj] += o2; }
                            bf16_t* p = Kf + (size_t)(b * 12 + h) * (8192 * 64) + ((size_t)((pos >> 5) * 4 + (wc & 1)) * 64 + (fq >> 1) * 32 + (pos & 31)) * 8 + (fq & 1) * 4;
                            *(u32x2*)p = pk4(o1); *(u32x2*)(p + 2 * 512) = pk4(o2); }
                        else { bf16_t* p = Q + (size_t)row * 768 + (tile - 3) * 256 + hl * 64 + d1; *(u32x2*)p = pk4(o1); *(u32x2*)(p + 32) = pk4(o2); } } }
            if (isk && kms) {
                const int b = u.pm >> 5, blk = u.pm & 31;
#pragma unroll
                for (int bj = 0; bj < 2; ++bj)
#pragma unroll
                    for (int j = 0; j < 4; ++j) { float a = cs1[bj][j], c = cs2[bj][j];
#pragma unroll
                        for (int o = 1; o < 16; o <<= 1) { a += __shfl_xor(a, o); c += __shfl_xor(c, o); }
                        if (fr == 0) { const int h = tile * 4 + bj * 2 + (wc >> 1); float* p = kms + ((size_t)((b * 12 + h) * 32 + blk)) * 64 + d1 + j; atomicAdd(p, a); atomicAdd(p + 32, c); } }
            }
        } else {
#pragma unroll
            for (int ai = 0; ai < 2; ++ai)
#pragma unroll
                for (int m = 0; m < 4; ++m) { const int row = row0 + ai * HALF + m * 16; const float rs = rstd_of(ss[row]) * c2;
#pragma unroll
                    for (int bj = 0; bj < 2; ++bj)
#pragma unroll
                        for (int n = 0; n < 2; ++n) *(u32x2*)(QM + (size_t)row * 256 + bj * HALF + wc * 32 + n * 16 + fq * 4) = pk4(acc[ai][bj][m][n] * rs); }
        }
    }
};
struct EpiMemK {
    static constexpr bool PERM = false, AFTER_DRAIN = false;
    bf16_t* Kf; const float* ss;
    __device__ __forceinline__ void operator()(const f32x4 (&acc)[2][2][4][2], const Unit& u, int wr, int wc, int fr, int fq) const {
        const int row0 = u.pm * BM + wr * 64 + fr;
#pragma unroll
        for (int ai = 0; ai < 2; ++ai)
#pragma unroll
            for (int m = 0; m < 4; ++m) { const int row = row0 + ai * HALF + m * 16, b = row >> 8, key = row & 255; const float rs = rstd_of(ss[row]);
#pragma unroll
                for (int bj = 0; bj < 2; ++bj)
#pragma unroll
                    for (int n = 0; n < 2; ++n) { const int head = bj * 2 + (wc >> 1), ks = (wc & 1) * 2 + n;
                        bf16_t* p = Kf + (size_t)(b * 4 + head) * (256 * 64) + ((size_t)((key >> 5) * 4 + ks) * 64 + (fq >> 1) * 32 + (key & 31)) * 8 + (fq & 1) * 4;
                        *(u32x2*)p = pk4(acc[ai][bj][m][n] * rs); } }
    }
};
template <int LOGSEQ, int NH, int LOGD> struct EpiVt {
    static constexpr bool PERM = false, AFTER_DRAIN = false;
    bf16_t* Vf; const float* ss;
    __device__ __forceinline__ void operator()(const f32x4 (&acc)[2][2][4][2], const Unit& u, int wr, int wc, int fr, int fq) const {
        const int f0 = u.pm * BM + wr * 64 + fr, c0 = u.pn * BM + wc * 32 + fq * 4;
#pragma unroll
        for (int bj = 0; bj < 2; ++bj)
#pragma unroll
            for (int n = 0; n < 2; ++n) { const int c = c0 + bj * HALF + n * 16, b = c >> LOGSEQ, key = c & ((1 << LOGSEQ) - 1);
                const f32x4 s4 = *(const f32x4*)(ss + c); f32x4 rs; rs[0] = rstd_of(s4[0]); rs[1] = rstd_of(s4[1]); rs[2] = rstd_of(s4[2]); rs[3] = rstd_of(s4[3]);
#pragma unroll
                for (int ai = 0; ai < 2; ++ai)
#pragma unroll
                    for (int m = 0; m < 4; ++m) { const int f = f0 + ai * HALF + m * 16, head = f >> LOGD, d = f & ((1 << LOGD) - 1);
                        bf16_t* p = Vf + ((size_t)(b * NH + head) << (LOGSEQ + LOGD)) + ((size_t)(((key >> 5) * 2 + n) * (1 << (LOGD - 5)) + (d >> 5)) * 64 + (fq & 1) * 32 + (d & 31)) * 8 + (fq >> 1) * 4;
                        *(u32x2*)p = pk4(acc[ai][bj][m][n] * rs); } }
    }
};
template <bool FROM_F32, bool SCALE> struct EpiRes {
    static constexpr bool PERM = true, AFTER_DRAIN = false;
    const float* xin; bf16_t* x16; float* ssout; const float* ssin;
    __device__ __forceinline__ void operator()(const f32x4 (&acc)[2][2][4][2], const Unit& u, int wr, int wc, int fr, int fq) const {
        const int row0 = u.pm * BM + wr * 64 + fr, col0 = u.pn * BM + wc * 32 + fq * 8;
#pragma unroll
        for (int ai = 0; ai < 2; ++ai) {
            u32x4 w[4][2]; f32x4 xa[4][2][2]; float r2[4];
#pragma unroll
            for (int m = 0; m < 4; ++m) r2[m] = SCALE ? 1.0f / (ssin[row0 + ai * HALF + m * 16] * (1.0f / 1024.0f) + RMS_EPS) : 1.0f;
#pragma unroll
            for (int m = 0; m < 4; ++m)
#pragma unroll
                for (int bj = 0; bj < 2; ++bj) { const size_t off = (size_t)(row0 + ai * HALF + m * 16) * 1024 + col0 + bj * HALF;
                    if (FROM_F32) { xa[m][bj][0] = *(const f32x4*)(xin + off); xa[m][bj][1] = *(const f32x4*)(xin + off + 4); } else w[m][bj] = *(const u32x4*)(x16 + off); }
#pragma unroll
            for (int m = 0; m < 4; ++m) { const int row = row0 + ai * HALF + m * 16; float q = 0.f;
#pragma unroll
                for (int bj = 0; bj < 2; ++bj) { const size_t off = (size_t)row * 1024 + col0 + bj * HALF;
                    f32x4 x0, x1;
                    if (FROM_F32) { x0 = xa[m][bj][0]; x1 = xa[m][bj][1]; }
                    else { const u32x4 ww = w[m][bj];
                        x0[0] = __builtin_bit_cast(float, ww.x << 16); x0[1] = __builtin_bit_cast(float, ww.x & 0xffff0000u); x0[2] = __builtin_bit_cast(float, ww.y << 16); x0[3] = __builtin_bit_cast(float, ww.y & 0xffff0000u);
                        x1[0] = __builtin_bit_cast(float, ww.z << 16); x1[1] = __builtin_bit_cast(float, ww.z & 0xffff0000u); x1[2] = __builtin_bit_cast(float, ww.w << 16); x1[3] = __builtin_bit_cast(float, ww.w & 0xffff0000u); }
                    const f32x4 v0 = SCALE ? x0 + acc[ai][bj][m][0] * r2[m] : x0 + acc[ai][bj][m][0], v1 = SCALE ? x1 + acc[ai][bj][m][1] * r2[m] : x1 + acc[ai][bj][m][1];
                    u32x4 o; o.x = cvtpk(v0[0], v0[1]); o.y = cvtpk(v0[2], v0[3]); o.z = cvtpk(v1[0], v1[1]); o.w = cvtpk(v1[2], v1[3]);
                    *(u32x4*)(x16 + off) = o;
                    q += (v0[0] * v0[0] + v0[1] * v0[1]) + (v0[2] * v0[2] + v0[3] * v0[3]) + (v1[0] * v1[0] + v1[1] * v1[1]) + (v1[2] * v1[2] + v1[3] * v1[3]); }
                q += __shfl_xor(q, 16); q += __shfl_xor(q, 32);
                if (fq == 0) atomicAdd(ssout + row, q); }
        }
    }
};
struct EpiUp {
    static constexpr bool PERM = true, AFTER_DRAIN = false;
    bf16_t* H;
    __device__ __forceinline__ void operator()(const f32x4 (&acc)[2][2][4][2], const Unit& u, int wr, int wc, int fr, int fq) const {
        const int row0 = u.pm * BM + wr * 64 + fr, col0 = u.pn * BM + wc * 32 + fq * 8;
#pragma unroll
        for (int ai = 0; ai < 2; ++ai)
#pragma unroll
            for (int m = 0; m < 4; ++m) { const int row = row0 + ai * HALF + m * 16;
#pragma unroll
                for (int bj = 0; bj < 2; ++bj) { f32x4 v0 = acc[ai][bj][m][0], v1 = acc[ai][bj][m][1]; const f32x4 z = {0.f, 0.f, 0.f, 0.f};
                    v0 = __builtin_elementwise_max(v0, z); v1 = __builtin_elementwise_max(v1, z); v0 = v0 * v0; v1 = v1 * v1;
                    u32x4 o; o.x = cvtpk(v0[0], v0[1]); o.y = cvtpk(v0[2], v0[3]); o.z = cvtpk(v1[0], v1[1]); o.w = cvtpk(v1[2], v1[3]);
                    *(u32x4*)(H + (size_t)row * 4096 + col0 + bj * HALF) = o; } }
    }
};
template <class Epi, class Sched, bool ALIGN_EPI = false, bool SP2 = false>
__device__ __forceinline__ void gemm_phase(PG8_LAS unsigned char* lds, const Gemm g, const Sched& S, const Epi& E) {
    int tid_ = threadIdx.x; asm volatile("" : "+v"(tid_));
    const int tid = tid_, wid = __builtin_amdgcn_readfirstlane(tid >> 6), lane = tid & 63, wr = wid >> 2, wc = wid & 3, fr = lane & 15, fq = lane >> 4;
    const int K = g.K, nt = K / BK;
    unsigned voffA[2], voffB[2];
#pragma unroll
    for (int i = 0; i < 2; ++i) { int R, C; stage_rc(tid * 16 + i * 8192, R, C); const int Rb = Epi::PERM ? ((R & ~31) + perm32(R & 31)) : R;
        voffA[i] = (unsigned)(R * K + C) * 2u; voffB[i] = (unsigned)(Rb * K + C) * 2u; }
    const size_t kstep = (size_t)(BK * 2);
    const size_t hstep = (size_t)HALF * K * 2;
    const size_t tstep = 2 * hstep;
    const unsigned ldsw = (unsigned)wid * 1024u;
    const int aoff = lds_byte(wr * 64 + fr, fq * 8), boff = lds_byte(wc * 32 + fr, fq * 8);
#define PG8_SA(b, h) (((b) * 2 + (h)) * HTB)
#define PG8_SB(b, h) ((4 + (b) * 2 + (h)) * HTB)
#define PG8_STAGE(bufoff, gbase, voff) do { _Pragma("unroll") for (int _i = 0; _i < 2; ++_i) \
        __builtin_amdgcn_global_load_lds((const unsigned*)((const char*)(gbase) + (voff)[_i]), (PG8_LAS unsigned*)(lds + (bufoff) + ldsw + _i * 8192), 16, 0, 0); } while (0)
#define PG8_LDA(dst, b, h) do { _Pragma("unroll") for (int m = 0; m < 4; ++m) _Pragma("unroll") for (int k = 0; k < 2; ++k) dst[m][k] = *(const PG8_LAS bf16x8*)(lds + PG8_SA(b, h) + aoff + m * 2048 + k * 1024); } while (0)
#define PG8_LDB(dst, b, h) do { _Pragma("unroll") for (int n = 0; n < 2; ++n) _Pragma("unroll") for (int k = 0; k < 2; ++k) dst[n][k] = *(const PG8_LAS bf16x8*)(lds + PG8_SB(b, h) + boff + n * 2048 + k * 1024); } while (0)
#define PG8_MMA(ai, bj, At, Bt) do { __builtin_amdgcn_s_setprio(1); _Pragma("unroll") for (int m = 0; m < 4; ++m) _Pragma("unroll") for (int n = 0; n < 2; ++n) _Pragma("unroll") for (int k = 0; k < 2; ++k) \
        acc[ai][bj][m][n] = __builtin_amdgcn_mfma_f32_16x16x32_bf16(Bt[n][k], At[m][k], acc[ai][bj][m][n], 0, 0, 0); __builtin_amdgcn_s_setprio(0); } while (0)
#define PG8_WAIT_V(n) asm volatile("s_waitcnt vmcnt(" #n ")" ::: "memory")
#define PG8_WAIT_L(n) asm volatile("s_waitcnt lgkmcnt(" #n ")" ::: "memory")
#define PG8_BAR __builtin_amdgcn_s_barrier()
#define PG8_SCHED __builtin_amdgcn_sched_barrier(0)
    Unit cur, nxt; int ui = 0;
    if (!S.next(0, cur)) return;
    f32x4 acc[2][2][4][2];
#pragma unroll
    for (int a = 0; a < 2; ++a)
#pragma unroll
        for (int b = 0; b < 2; ++b)
#pragma unroll
            for (int m = 0; m < 4; ++m)
#pragma unroll
                for (int n = 0; n < 2; ++n) acc[a][b][m][n] = (f32x4){0.f, 0.f, 0.f, 0.f};
    bf16x8 At[4][2], B0[2][2], B1[2][2];
    const char* cA = (const char*)g.A + (size_t)cur.pm * tstep; const char* cB = (const char*)g.Bt + (size_t)cur.pn * tstep;
    S.a_ready(cur);
    if constexpr (SP2) {
        PG8_STAGE(PG8_SB(0, 0), cB, voffB); PG8_STAGE(PG8_SB(0, 1), cB + hstep, voffB); PG8_STAGE(PG8_SA(0, 0), cA, voffA); PG8_STAGE(PG8_SA(0, 1), cA + hstep, voffA);
        if (wr == 1) PG8_BAR;
        PG8_WAIT_V(2); PG8_BAR;
        PG8_STAGE(PG8_SB(1, 0), cB + kstep, voffB); PG8_STAGE(PG8_SA(1, 0), cA + kstep, voffA); PG8_STAGE(PG8_SB(1, 1), cB + hstep + kstep, voffB);
        PG8_WAIT_V(6); PG8_BAR;
    } else {
        PG8_STAGE(PG8_SB(0, 0), cB, voffB); PG8_STAGE(PG8_SA(0, 0), cA, voffA); PG8_STAGE(PG8_SB(0, 1), cB + hstep, voffB); PG8_STAGE(PG8_SA(0, 1), cA + hstep, voffA);
        if (wr == 1) PG8_BAR;
        PG8_WAIT_V(4); PG8_BAR;
        PG8_STAGE(PG8_SB(1, 0), cB + kstep, voffB); PG8_STAGE(PG8_SA(1, 0), cA + kstep, voffA); PG8_STAGE(PG8_SB(1, 1), cB + hstep + kstep, voffB);
        PG8_WAIT_V(6); PG8_BAR;
    }
    for (;;) {
        const bool has_next = S.next(ui + 1, nxt);
        const char* nA = has_next ? (const char*)g.A + (size_t)nxt.pm * tstep : cA; const char* nB = has_next ? (const char*)g.Bt + (size_t)nxt.pn * tstep : cB;
        for (int t = 0; t < nt; t += 2) {
            const bool last = (t == nt - 2);
            const char* a1 = cA + (size_t)(t + 1) * kstep;
            const char* a2 = last ? nA : cA + (size_t)(t + 2) * kstep; const char* b2 = last ? nB : cB + (size_t)(t + 2) * kstep;
            const char* a3 = a2 + kstep; const char* b3 = b2 + kstep;
            if (last && has_next) S.a_ready(nxt);
            if constexpr (SP2) {
            PG8_LDB(B0, 0, 0); PG8_LDB(B1, 0, 1); PG8_SCHED; PG8_LDA(At, 0, 0); PG8_STAGE(PG8_SA(1, 1), a1 + hstep, voffA);
            PG8_WAIT_V(8); PG8_WAIT_L(0); PG8_BAR; PG8_MMA(0, 0, At, B0); PG8_MMA(0, 1, At, B1); PG8_BAR; PG8_SCHED;
            PG8_LDA(At, 0, 1); PG8_STAGE(PG8_SB(0, 0), b2, voffB); PG8_STAGE(PG8_SB(0, 1), b2 + hstep, voffB); PG8_STAGE(PG8_SA(0, 0), a2, voffA);
            PG8_WAIT_V(8); PG8_WAIT_L(0); PG8_BAR; PG8_MMA(1, 0, At, B0); PG8_MMA(1, 1, At, B1); PG8_BAR; PG8_SCHED;
            PG8_LDB(B0, 1, 0); PG8_LDB(B1, 1, 1); PG8_SCHED; PG8_LDA(At, 1, 0); PG8_STAGE(PG8_SA(0, 1), a2 + hstep, voffA);
            PG8_WAIT_V(8); PG8_WAIT_L(0); PG8_BAR; PG8_MMA(0, 0, At, B0); PG8_MMA(0, 1, At, B1); PG8_BAR; PG8_SCHED;
            PG8_LDA(At, 1, 1); PG8_STAGE(PG8_SB(1, 0), b3, voffB); PG8_STAGE(PG8_SB(1, 1), b3 + hstep, voffB); PG8_STAGE(PG8_SA(1, 0), a3, voffA);
            PG8_WAIT_V(8); PG8_WAIT_L(0); PG8_BAR; PG8_MMA(1, 0, At, B0); PG8_MMA(1, 1, At, B1); PG8_BAR; PG8_SCHED;
            } else {
            PG8_LDB(B0, 0, 0); PG8_SCHED; PG8_LDA(At, 0, 0); PG8_STAGE(PG8_SA(1, 1), a1 + hstep, voffA);
            PG8_WAIT_L(8); PG8_BAR; PG8_WAIT_L(0); PG8_MMA(0, 0, At, B0); PG8_BAR; PG8_SCHED;
            PG8_LDB(B1, 0, 1); PG8_STAGE(PG8_SB(0, 0), b2, voffB);
            PG8_BAR; PG8_WAIT_L(0); PG8_MMA(0, 1, At, B1); PG8_BAR;
            PG8_LDA(At, 0, 1); PG8_STAGE(PG8_SA(0, 0), a2, voffA);
            PG8_BAR; PG8_WAIT_L(0); PG8_MMA(1, 0, At, B0); PG8_BAR; PG8_SCHED;
            PG8_STAGE(PG8_SB(0, 1), b2 + hstep, voffB);
            PG8_WAIT_V(6); PG8_BAR; PG8_MMA(1, 1, At, B1); PG8_BAR;
            PG8_LDB(B0, 1, 0); PG8_SCHED; PG8_LDA(At, 1, 0); PG8_STAGE(PG8_SA(0, 1), a2 + hstep, voffA);
            PG8_WAIT_L(8); PG8_BAR; PG8_WAIT_L(0); PG8_MMA(0, 0, At, B0); PG8_BAR; PG8_SCHED;
            PG8_LDB(B1, 1, 1); PG8_STAGE(PG8_SB(1, 0), b3, voffB);
            PG8_BAR; PG8_WAIT_L(0); PG8_MMA(0, 1, At, B1); PG8_BAR;
            PG8_LDA(At, 1, 1); PG8_STAGE(PG8_SA(1, 0), a3, voffA);
            PG8_BAR; PG8_WAIT_L(0); PG8_MMA(1, 0, At, B0); PG8_BAR; PG8_SCHED;
            PG8_STAGE(PG8_SB(1, 1), b3 + hstep, voffB);
            PG8_WAIT_V(6); PG8_BAR; PG8_MMA(1, 1, At, B1); PG8_BAR;
            }
        }
        if constexpr (ALIGN_EPI) { if (wr == 0) PG8_BAR; }
        if constexpr (!Epi::AFTER_DRAIN) { E(acc, cur, wr, wc, fr, fq); S.done(cur); }
        if (!has_next) break;
#pragma unroll
        for (int a = 0; a < 2; ++a)
#pragma unroll
            for (int b = 0; b < 2; ++b)
#pragma unroll
                for (int m = 0; m < 4; ++m)
#pragma unroll
                    for (int n = 0; n < 2; ++n) acc[a][b][m][n] = (f32x4){0.f, 0.f, 0.f, 0.f};
        cur = nxt; cA = nA; cB = nB; ++ui;
        if constexpr (ALIGN_EPI) { if (wr == 1) PG8_BAR; }
    }
    PG8_WAIT_V(0);
    if constexpr (!ALIGN_EPI) { if (wr == 0) PG8_BAR; }
    PG8_BAR;
    if constexpr (Epi::AFTER_DRAIN) { E.fused(acc, cur, wr, wc, fr, fq, lds, wid, lane); S.done(cur); }
#undef PG8_SA
#undef PG8_SB
#undef PG8_STAGE
#undef PG8_LDA
#undef PG8_LDB
#undef PG8_MMA
#undef PG8_WAIT_V
#undef PG8_WAIT_L
#undef PG8_BAR
#undef PG8_SCHED
}
}

#define LAS __attribute__((address_space(3)))
#define GAS __attribute__((address_space(1)))
typedef unsigned short bf16_t;
typedef short bf16x8 __attribute__((ext_vector_type(8)));
typedef float f32x4 __attribute__((ext_vector_type(4)));
typedef float f32x16 __attribute__((ext_vector_type(16)));
typedef unsigned u32x4 __attribute__((ext_vector_type(4)));
typedef unsigned u32x2 __attribute__((ext_vector_type(2)));
typedef int i32x4 __attribute__((ext_vector_type(4)));
using pg8::cvtpk; using pg8::pk4; using pg8::rstd_of;

constexpr int NWAVES = 8, NTHREADS = 512;
constexpr int BATCH = 4, SEQ = 8192, DM = 1024, MTOK = BATCH * SEQ, FF = 4096, MEMLEN = 256, MEMROWS = BATCH * MEMLEN;
constexpr float C2 = 0.125f * 1.4426950408889634f;
constexpr size_t MiB = 1u << 20;
constexpr size_t WS_SS = 0;
constexpr size_t WS_KMS = 512 * 1024;
constexpr size_t WS_SS0 = 1 * MiB, WS_SSM = WS_SS0 + 128 * 1024;
constexpr size_t WS_COS = 2 * MiB, WS_SIN = 3 * MiB;
constexpr size_t WS_BAR = 1 * MiB + 512 * 1024;
constexpr size_t WS_WA_IN = 4 * MiB, WS_WA_V = 8 * MiB, WS_WA_OUT = 10 * MiB, WS_WA_UP = 12 * MiB, WS_WA_DOWN = 20 * MiB, WS_WB_IN = 28 * MiB, WS_WB_V = 32 * MiB, WS_WB_OUT = 34 * MiB,
                 WS_WB_UP = 36 * MiB, WS_WB_DOWN = 44 * MiB, WS_WA_MEM = 52 * MiB, WS_WB_MEM = 53 * MiB, WS_MEM16 = 54 * MiB,
                 WS_MKA = 56 * MiB, WS_MVA = 56 * MiB + 512 * 1024, WS_MKB = 57 * MiB, WS_MVB = 57 * MiB + 512 * 1024;
constexpr size_t WS_X16 = 64 * MiB, WS_ATT = 128 * MiB, WS_BIG = 192 * MiB, WS_END = 490 * MiB;
constexpr size_t BG_QA = 0, BG_KA = 48 * MiB, BG_VA = 96 * MiB, BG_OA = 144 * MiB, BG_QMA = 240 * MiB;
constexpr size_t BG_QB = 0, BG_KB = 48 * MiB, BG_VB = 96 * MiB, BG_QMB = 144 * MiB, BG_PART = 160 * MiB;
constexpr int PSTR = 68;
constexpr size_t PART_BYTES = (size_t)256 * 4 * PSTR * 4;
static_assert(BG_PART + 256 * PART_BYTES <= 256 * MiB, "partials fit");
constexpr int LDS_BYTES = 147456;

struct WDesc { const float* src; const float* gain; bf16_t* dst; int K, N, col0, ncols, rowoff, perm, start, pad; };
constexpr int NWD = 16;
struct Params {
    const float *x, *mem, *a_lambda, *a_subln, *final_norm;
    float* out; unsigned char* ws;
    WDesc wd[NWD]; int nitems; int nearly;
    float inv[32];
};

__device__ __forceinline__ unsigned f2bf(float f) { unsigned u = __builtin_bit_cast(unsigned, f); return (u + 0x7fffu + ((u >> 16) & 1u)) >> 16; }
__device__ __forceinline__ float bf2f(unsigned h) { return __builtin_bit_cast(float, h << 16); }
__device__ __forceinline__ float wave_sum(float v) {
#pragma unroll
    for (int o = 1; o < 64; o <<= 1) v += __shfl_xor(v, o);
    return v;
}
__device__ __forceinline__ int crow(int r, int hi) { return (r & 3) + 8 * (r >> 2) + 4 * hi; }
#define MFMA32(a, b, c) __builtin_amdgcn_mfma_f32_32x32x16_bf16((a), (b), (c), 0, 0, 0)

__device__ __forceinline__ unsigned long long rfl64(unsigned long long v) { const unsigned lo = __builtin_amdgcn_readfirstlane((unsigned)v), hi = __builtin_amdgcn_readfirstlane((unsigned)(v >> 32)); return ((unsigned long long)hi << 32) | lo; }
__device__ __forceinline__ void p0_transpose_item(const WDesc& w, LAS float* scr, int item, int lane) {
    const int nblk = w.ncols / 32, kb = item / nblk, nb = item % nblk, k0 = 64 * kb, n0 = 32 * nb;
    f32x4 tv[8];
#pragma unroll
    for (int i = 0; i < 8; ++i) tv[i] = __builtin_nontemporal_load((const f32x4*)(w.src + (size_t)(k0 + (lane >> 3) + 8 * i) * w.N + w.col0 + n0 + 4 * (lane & 7)));
    const float g0 = w.gain ? w.gain[k0 + lane] : 1.f;
#pragma unroll
    for (int i = 0; i < 8; ++i) { const int kk = (lane >> 3) + 8 * i; const float g = __shfl(g0, kk); LAS float* d = scr + kk * 33 + 4 * (lane & 7);
        d[0] = tv[i][0] * g; d[1] = tv[i][1] * g; d[2] = tv[i][2] * g; d[3] = tv[i][3] * g; }
    asm volatile("s_waitcnt lgkmcnt(0)" ::: "memory");
    const int c = lane & 7;
#pragma unroll
    for (int j = 0; j < 4; ++j) { const int n = (lane >> 3) + 8 * j; const LAS float* s = scr + (8 * c) * 33 + n;
        u32x4 o; o.x = cvtpk(s[0 * 33], s[1 * 33]); o.y = cvtpk(s[2 * 33], s[3 * 33]); o.z = cvtpk(s[4 * 33], s[5 * 33]); o.w = cvtpk(s[6 * 33], s[7 * 33]);
        int nn = n0 + n; if (w.perm) nn = (nn & ~0x30) | ((nn & 0x10) << 1) | ((nn & 0x20) >> 1);
        *(u32x4*)(w.dst + (size_t)(w.rowoff + nn) * w.K + k0 + 8 * c) = o; }
    asm volatile("s_waitcnt lgkmcnt(0)" ::: "memory");
}
template <int NR> __device__ __forceinline__ void rows_to_bf16(const float* x0, bf16_t* o0, float* ssp, size_t rstride, int lane) {
    f32x4 v[NR][4];
#pragma unroll
    for (int q = 0; q < NR; ++q) { const f32x4* xr = (const f32x4*)(x0 + q * rstride * 1024) + 2 * lane;
#pragma unroll
        for (int j = 0; j < 2; ++j) { v[q][2 * j] = __builtin_nontemporal_load(xr + 128 * j); v[q][2 * j + 1] = __builtin_nontemporal_load(xr + 128 * j + 1); } }
#pragma unroll
    for (int q = 0; q < NR; ++q) { float s = 0.f;
#pragma unroll
        for (int j = 0; j < 4; ++j) s += (v[q][j][0] * v[q][j][0] + v[q][j][1] * v[q][j][1]) + (v[q][j][2] * v[q][j][2] + v[q][j][3] * v[q][j][3]);
        s = wave_sum(s);
        u32x4* o16 = (u32x4*)(o0 + q * rstride * 1024) + lane;
#pragma unroll
        for (int j = 0; j < 2; ++j) { u32x4 o; o.x = cvtpk(v[q][2 * j][0], v[q][2 * j][1]); o.y = cvtpk(v[q][2 * j][2], v[q][2 * j][3]); o.z = cvtpk(v[q][2 * j + 1][0], v[q][2 * j + 1][1]); o.w = cvtpk(v[q][2 * j + 1][2], v[q][2 * j + 1][3]); o16[64 * j] = o; }
        if (lane == 0) ssp[q * rstride] = s; }
}
__device__ __forceinline__ void sincos_acc(float a, float& s, float& c) {
    const double x = (double)a, k = __builtin_rint(x * 0.63661977236758134308);
    double r = x - k * 1.57079632679489661923; r -= k * 6.123233995736766e-17;
    const int q = (int)k & 3; const double r2 = r * r;
    const double sp = r * (1.0 + r2 * (-1.0 / 6 + r2 * (1.0 / 120 + r2 * (-1.0 / 5040 + r2 * (1.0 / 362880 + r2 * (-1.0 / 39916800 + r2 * (1.0 / 6227020800.0)))))));
    const double cp = 1.0 + r2 * (-0.5 + r2 * (1.0 / 24 + r2 * (-1.0 / 720 + r2 * (1.0 / 40320 + r2 * (-1.0 / 3628800 + r2 * (1.0 / 479001600 + r2 * (-1.0 / 87178291200.0)))))));
    const double ss = (q == 0) ? sp : (q == 1) ? cp : (q == 2) ? -sp : -cp, cc = (q == 0) ? cp : (q == 1) ? -sp : (q == 2) ? -cp : sp;
    s = (float)ss; c = (float)cc;
}

__device__ __forceinline__ void flash_wave(const bf16x8 (&qf)[4], const bf16_t* Kf, const bf16_t* Vf, int nchunk, int qlim, bool masked, LAS float* sc, int lane,
                                           float& m, float& l, f32x16& o0, f32x16& o1) {
    const int hh = lane >> 5;
    bf16x8 ka[8], vb[8];
#pragma unroll
    for (int f = 0; f < 8; ++f) { ka[f] = *(const bf16x8*)(Kf + lane * 8 + f * 512); vb[f] = *(const bf16x8*)(Vf + lane * 8 + f * 512); }
#pragma unroll 1
    for (int c = 0; c < nchunk; ++c) {
        const size_t nx = (size_t)(c + 1 < nchunk ? c + 1 : c) * 4096 + lane * 8;
        bf16x8 kn[8], vn[8];
#pragma unroll
        for (int f = 0; f < 8; ++f) { kn[f] = *(const bf16x8*)(Kf + nx + f * 512); vn[f] = *(const bf16x8*)(Vf + nx + f * 512); }
        f32x16 p0 = {}, p1 = {};
#pragma unroll
        for (int ks = 0; ks < 4; ++ks) { p0 = MFMA32(ka[ks], qf[ks], p0); p1 = MFMA32(ka[4 + ks], qf[ks], p1); }
        if (masked) {
#pragma unroll
            for (int i = 0; i < 16; ++i) { const int kc = (i & 3) + 8 * (i >> 2), t0 = qlim - c * 64 - 4 * hh; if (kc > t0) p0[i] = -INFINITY; if (kc + 32 > t0) p1[i] = -INFINITY; }
        }
        float rm = fmaxf(p0[0], p1[0]);
#pragma unroll
        for (int i = 1; i < 16; ++i) rm = fmaxf(rm, fmaxf(p0[i], p1[i]));
        rm = fmaxf(rm, __shfl_xor(rm, 32));
        const float mn = fmaxf(m, rm), alpha = __builtin_amdgcn_exp2f(m - mn);
        float sum = 0.f;
#pragma unroll
        for (int i = 0; i < 16; ++i) { p0[i] = __builtin_amdgcn_exp2f(p0[i] - mn); p1[i] = __builtin_amdgcn_exp2f(p1[i] - mn); sum += p0[i] + p1[i]; }
        l = l * alpha + sum; m = mn;
        if (__any(alpha != 1.0f)) {
            sc[lane & 31] = alpha;
#pragma unroll
            for (int g = 0; g < 4; ++g) { const f32x4 a = *(const LAS f32x4*)(sc + 8 * g + 4 * hh);
#pragma unroll
                for (int e = 0; e < 4; ++e) { o0[4 * g + e] *= a[e]; o1[4 * g + e] *= a[e]; } }
        }
#pragma unroll
        for (int s = 0; s < 2; ++s) {
            u32x4 w0, w1;
#pragma unroll
            for (int e = 0; e < 4; ++e) { w0[e] = cvtpk(p0[8 * s + 2 * e], p0[8 * s + 2 * e + 1]); w1[e] = cvtpk(p1[8 * s + 2 * e], p1[8 * s + 2 * e + 1]); }
            const bf16x8 a0 = __builtin_bit_cast(bf16x8, w0), a1 = __builtin_bit_cast(bf16x8, w1);
            o0 = MFMA32(a0, vb[s * 2 + 0], o0); o1 = MFMA32(a0, vb[s * 2 + 1], o1);
            o0 = MFMA32(a1, vb[4 + s * 2 + 0], o0); o1 = MFMA32(a1, vb[4 + s * 2 + 1], o1);
        }
#pragma unroll
        for (int f = 0; f < 8; ++f) { ka[f] = kn[f]; vb[f] = vn[f]; }
    }
}
__device__ __forceinline__ void mem_attn_phase(const bf16_t* QM, const bf16_t* MK, const bf16_t* MV, bf16_t* att, LAS float* sc, int gw, int ngw, int lane) {
    const int r = lane & 31, hh = lane >> 5;
    for (int it = gw; it < (MTOK / 32) * 4; it += ngw) {
        asm volatile("" : "+s"(QM), "+s"(MK), "+s"(MV), "+s"(att));
        const int head = it & 3, row0 = (it >> 2) * 32, b = row0 >> 13;
        bf16x8 qf[4];
#pragma unroll
        for (int ks = 0; ks < 4; ++ks) qf[ks] = *(const bf16x8*)(QM + (size_t)(row0 + r) * 256 + head * 64 + ks * 16 + hh * 8);
        float m = -INFINITY, l = 0.f; f32x16 o0 = {}, o1 = {};
        flash_wave(qf, MK + (size_t)(b * 4 + head) * (256 * 64), MV + (size_t)(b * 4 + head) * (256 * 64), 4, 1 << 30, false, sc, lane, m, l, o0, o1);
        l += __shfl_xor(l, 32);
        sc[r] = 1.0f / l;
#pragma unroll
        for (int g = 0; g < 4; ++g) { const f32x4 a = *(const LAS f32x4*)(sc + 8 * g + 4 * hh);
#pragma unroll
            for (int e = 0; e < 4; ++e) { const int i = 4 * g + e; bf16_t* p = att + (size_t)(row0 + crow(i, hh)) * 1024 + 768 + head * 64 + r;
                p[0] = (bf16_t)f2bf(o0[i] * a[e]); p[32] = (bf16_t)f2bf(o1[i] * a[e]); } }
    }
}
constexpr int ML_CNT = 0, ML_IST = 256, ML_LIST = 512, ML_SCR = 512 + 32 * 256 * 2, ML_SCR_STRIDE = 512;
#define TOP3_INSERT(g_, j_) do { const float gg_ = (g_); const int jj_ = (j_); const bool c0_ = gg_ > v0, c1_ = gg_ > v1, c2_ = gg_ > v2; \
    v2 = c1_ ? v1 : (c2_ ? gg_ : v2); i2 = c1_ ? i1 : (c2_ ? jj_ : i2); v1 = c0_ ? v0 : (c1_ ? gg_ : v1); i1 = c0_ ? i0 : (c1_ ? jj_ : i1); v0 = c0_ ? gg_ : v0; i0 = c0_ ? jj_ : i0; } while (0)
__device__ __forceinline__ void moba_phase(const bf16_t* Q, const bf16_t* Kf, const bf16_t* Vf, const float* kms, float* part, bf16_t* att, LAS unsigned char* lds, int tid) {
    const int lane = tid & 63, wave = __builtin_amdgcn_readfirstlane(tid >> 6), r = lane & 31, hh = lane >> 5;
    LAS int* cnt = (LAS int*)(lds + ML_CNT); LAS int* ist = (LAS int*)(lds + ML_IST); LAS unsigned short* list = (LAS unsigned short*)(lds + ML_LIST);
    LAS float* sc = (LAS float*)(lds + ML_SCR + wave * ML_SCR_STRIDE); LAS int* sci = (LAS int*)(sc + 32);
    const int nu = 48 * 32, G_ = gridDim.x;
    for (int u0 = blockIdx.x; u0 < nu; u0 += G_) {
        int cur, bh;
        if (G_ == 256) { const int x = u0 & 7, ci = (u0 >> 3) & 31, rho = u0 >> 8; bh = 6 * x + rho; cur = (rho & 1) ? ci : 31 - ci; }
        else { cur = 31 - u0 / 48; bh = u0 % 48; }
        const int b = bh / 12, h = bh % 12;
        const size_t tok0 = (size_t)b * SEQ + cur * 256;
        const bf16_t* Kbh = Kf + (size_t)bh * (SEQ * 64); const bf16_t* Vbh = Vf + (size_t)bh * (SEQ * 64);
        if (tid < 32) cnt[tid] = 0;
        __syncthreads();
        if (cur > 0) {
            bf16x8 qf[4];
#pragma unroll
            for (int ks = 0; ks < 4; ++ks) qf[ks] = *(const bf16x8*)(Q + (tok0 + wave * 32 + r) * 768 + h * 64 + ks * 16 + hh * 8);
            f32x16 ga = {};
            const float* kr = kms + ((size_t)(bh * 32 + r)) * 64 + hh * 8;
#pragma unroll
            for (int ks = 0; ks < 4; ++ks) { const f32x4 x0 = *(const f32x4*)(kr + ks * 16), x1 = *(const f32x4*)(kr + ks * 16 + 4);
                u32x4 hi, lo;
#pragma unroll
                for (int e = 0; e < 2; ++e) { const float a0 = x0[2 * e], a1 = x0[2 * e + 1], b0 = x1[2 * e], b1 = x1[2 * e + 1];
                    hi[e] = cvtpk(a0, a1); hi[2 + e] = cvtpk(b0, b1);
                    lo[e] = cvtpk(a0 - bf2f(hi[e] & 0xffffu), a1 - bf2f(hi[e] >> 16)); lo[2 + e] = cvtpk(b0 - bf2f(hi[2 + e] & 0xffffu), b1 - bf2f(hi[2 + e] >> 16)); }
                ga = MFMA32(__builtin_bit_cast(bf16x8, hi), qf[ks], ga); ga = MFMA32(__builtin_bit_cast(bf16x8, lo), qf[ks], ga); }
            float v0 = -INFINITY, v1 = -INFINITY, v2 = -INFINITY; int i0 = -1, i1 = -1, i2 = -1;
#pragma unroll
            for (int i = 0; i < 16; ++i) { const int j = crow(i, hh); const float g = (j < cur) ? ga[i] : -INFINITY; TOP3_INSERT(g, j); }
            const float p0 = __shfl_xor(v0, 32), p1 = __shfl_xor(v1, 32), p2 = __shfl_xor(v2, 32); const int q0 = __shfl_xor(i0, 32), q1 = __shfl_xor(i1, 32), q2 = __shfl_xor(i2, 32);
            TOP3_INSERT(p0, q0); TOP3_INSERT(p1, q1); TOP3_INSERT(p2, q2);
            if (hh == 0) { const int qi = wave * 32 + r;
                if (i0 >= 0) { const int p = atomicAdd((int*)&cnt[i0], 1); list[i0 * 256 + p] = (unsigned short)(qi | (0 << 8)); }
                if (i1 >= 0) { const int p = atomicAdd((int*)&cnt[i1], 1); list[i1 * 256 + p] = (unsigned short)(qi | (1 << 8)); }
                if (i2 >= 0) { const int p = atomicAdd((int*)&cnt[i2], 1); list[i2 * 256 + p] = (unsigned short)(qi | (2 << 8)); } }
        }
        __syncthreads();
        if (tid == 0) { int a = 0; for (int j = 0; j < 32; ++j) { ist[j] = a; a += (j < cur) ? ((cnt[j] + 31) >> 5) : 0; } ist[32] = a; }
        __syncthreads();
        const int nsel = ist[32];
        for (int x = wave; x < nsel + 8; x += NWAVES) {
            int j, qi, slot, nchunk, qlim; bool valid, masked;
            if (x < nsel) { j = 0; while (ist[j + 1] <= x) ++j; const int g = x - ist[j], n = cnt[j], p = g * 32 + r; valid = p < n;
                const int e = list[j * 256 + (valid ? p : n - 1)]; qi = e & 255; slot = e >> 8; nchunk = 4; qlim = 1 << 30; masked = false; }
            else { const int g = x - nsel; j = cur; qi = g * 32 + r; slot = 3; valid = true; nchunk = (g >> 1) + 1; qlim = qi; masked = true; }
            bf16x8 qf[4];
#pragma unroll
            for (int ks = 0; ks < 4; ++ks) qf[ks] = *(const bf16x8*)(Q + (tok0 + qi) * 768 + h * 64 + ks * 16 + hh * 8);
            float m = -INFINITY, l = 0.f; f32x16 o0 = {}, o1 = {};
            flash_wave(qf, Kbh + (size_t)j * (256 * 64), Vbh + (size_t)j * (256 * 64), nchunk, qlim, masked, sc, lane, m, l, o0, o1);
            l += __shfl_xor(l, 32);
            sci[r] = valid ? (qi * 4 + slot) : -1;
#pragma unroll
            for (int g = 0; g < 4; ++g) { const i32x4 rid = *(const LAS i32x4*)(sci + 8 * g + 4 * hh);
#pragma unroll
                for (int e = 0; e < 4; ++e) if (rid[e] >= 0) { float* p = part + (size_t)rid[e] * PSTR + r; p[0] = o0[4 * g + e]; p[32] = o1[4 * g + e]; } }
            if (valid && hh == 0) { float* p = part + (size_t)(qi * 4 + slot) * PSTR + 64; p[0] = m; p[1] = l; }
        }
        __syncthreads();
        { const int qi = tid >> 1, dh = tid & 1, nv = cur < 3 ? cur : 3;
            const float* pq = part + (size_t)(qi * 4) * PSTR;
            float mk[4], lk[4]; float M = pq[3 * PSTR + 64]; mk[3] = M; lk[3] = pq[3 * PSTR + 65];
#pragma unroll
            for (int k = 0; k < 3; ++k) { if (k < nv) { mk[k] = pq[k * PSTR + 64]; lk[k] = pq[k * PSTR + 65]; M = fmaxf(M, mk[k]); } else { mk[k] = -INFINITY; lk[k] = 0.f; } }
            float wk[4], L = 0.f;
#pragma unroll
            for (int k = 0; k < 4; ++k) { wk[k] = (k == 3 || k < nv) ? __builtin_amdgcn_exp2f(mk[k] - M) : 0.f; L += wk[k] * lk[k]; }
            const float invL = 1.0f / L;
            bf16_t* op = att + (tok0 + qi) * 1024 + h * 64 + dh * 32;
#pragma unroll
            for (int c = 0; c < 4; ++c) { f32x4 a0 = {0.f, 0.f, 0.f, 0.f}, a1 = {0.f, 0.f, 0.f, 0.f};
#pragma unroll
                for (int k = 0; k < 4; ++k) if (k == 3 || k < nv) { const f32x4* s = (const f32x4*)(pq + k * PSTR + dh * 32 + c * 8); a0 += s[0] * wk[k]; a1 += s[1] * wk[k]; }
                a0 = a0 * invL; a1 = a1 * invL;
                u32x4 o; o.x = cvtpk(a0[0], a0[1]); o.y = cvtpk(a0[2], a0[3]); o.z = cvtpk(a1[0], a1[1]); o.w = cvtpk(a1[2], a1[3]);
                *(u32x4*)(op + c * 8) = o; }
        }
        __syncthreads();
    }
}
__device__ __forceinline__ void diff_combine_phase(const bf16_t* O, const float* lamp, const float* subln, bf16_t* att, int gw, int ngw, int lane) {
    const float s01 = wave_sum(lamp[lane] * lamp[64 + lane]), s23 = wave_sum(lamp[128 + lane] * lamp[192 + lane]);
    const float lam_init = 0.2f, lam = expf(s01) - expf(s23) + lam_init;
    const int sub = lane >> 4, e16 = lane & 15;
    const f32x4 g0 = *(const f32x4*)(subln + e16 * 8), g1 = *(const f32x4*)(subln + e16 * 8 + 4);
    for (int it0 = gw; it0 + 3 * ngw < MTOK * 6 / 4; it0 += 4 * ngw) {
        u32x4 av[4], cv[4];
#pragma unroll
        for (int q = 0; q < 4; ++q) { const int pr = (it0 + q * ngw) * 4 + sub, row = pr / 6, hd = pr % 6; const bf16_t* p1 = O + (size_t)row * 1536 + hd * 256 + e16 * 8; av[q] = __builtin_nontemporal_load((const u32x4*)p1); cv[q] = __builtin_nontemporal_load((const u32x4*)(p1 + 128)); }
#pragma unroll
        for (int q = 0; q < 4; ++q) { const int pr = (it0 + q * ngw) * 4 + sub, row = pr / 6, hd = pr % 6; const u32x4 a = av[q], c = cv[q];
        float o[8]; float qq = 0.f;
#pragma unroll
        for (int e = 0; e < 4; ++e) { o[2 * e] = bf2f(a[e] & 0xffffu) - lam * bf2f(c[e] & 0xffffu); o[2 * e + 1] = bf2f(a[e] >> 16) - lam * bf2f(c[e] >> 16); qq += o[2 * e] * o[2 * e] + o[2 * e + 1] * o[2 * e + 1]; }
#pragma unroll
        for (int s = 1; s < 16; s <<= 1) qq += __shfl_xor(qq, s);
        const float rs = (1.0f / sqrtf(qq * (1.0f / 128.0f) + 1e-6f)) * (1.0f - lam_init);
        u32x4 w; w.x = cvtpk(o[0] * rs * g0[0], o[1] * rs * g0[1]); w.y = cvtpk(o[2] * rs * g0[2], o[3] * rs * g0[3]); w.z = cvtpk(o[4] * rs * g1[0], o[5] * rs * g1[1]); w.w = cvtpk(o[6] * rs * g1[2], o[7] * rs * g1[3]);
        *(u32x4*)(att + (size_t)row * 1024 + hd * 128 + e16 * 8) = w; }
    }
}
constexpr int DA_KS = 8192, DA_VS = 16384, DA_KOFF = 0, DA_VOFF = 3 * DA_KS, DA_SCR = DA_VOFF + 2 * DA_VS;
constexpr float DA_THR = 8.0f;
__device__ __forceinline__ void diff_attn_phase(const bf16_t* Q, const bf16_t* Kf, const bf16_t* Vf, bf16_t* O, LAS unsigned char* lds, int tid) {
    const int lane = tid & 63, wave = __builtin_amdgcn_readfirstlane(tid >> 6), r = lane & 31, hh = lane >> 5;
    LAS float* sc = (LAS float*)(lds + DA_SCR + wave * 512);
    if (wave >= 4) __builtin_amdgcn_s_setprio(1);
    const int G = gridDim.x, bx = blockIdx.x, vcu = (G % 8 == 0) ? (bx % 8) * (G / 8) + bx / 8 : bx;
#pragma unroll 1
    for (int pi = vcu; pi < 768; pi += G) {
        asm volatile("" : "+s"(Q), "+s"(Kf), "+s"(Vf), "+s"(O));
        const int bvh = pi >> 4, s16 = pi & 15, b = bvh / 12, vh = bvh % 12;
        const bf16_t* Kseq = Kf + (size_t)(b * 12 + vh) * (SEQ * 64); const bf16_t* Vseq = Vf + (size_t)(b * 6 + (vh >> 1)) * (SEQ * 128);
#pragma unroll 1
        for (int half = 0; half < 2; ++half) {
            asm volatile("" : "+s"(Q), "+s"(O));
            const int qb = half ? 31 - s16 : s16, nc = 4 * (qb + 1);
            const int nact = nc - 4 + ((wave * 32 + 31) >> 6) + 1;
            const size_t tok0 = (size_t)b * SEQ + qb * 256 + wave * 32;
            bf16x8 qf[4];
#pragma unroll
            for (int ks = 0; ks < 4; ++ks) qf[ks] = *(const bf16x8*)(Q + (tok0 + r) * 768 + vh * 64 + ks * 16 + hh * 8);
            const bf16_t* srck = Kseq + tid * 8;
            const bf16_t* srcv = Vseq + tid * 8;
#define DA_DMA_K(cc, slot) __builtin_amdgcn_global_load_lds((const GAS unsigned*)(srck + (size_t)(cc) * 4096), (LAS unsigned*)(lds + DA_KOFF + (slot) * DA_KS + wave * 1024), 16, 0, 0)
#define DA_DMA_V(cc, slot) do { __builtin_amdgcn_global_load_lds((const GAS unsigned*)(srcv + (size_t)(cc) * 8192), (LAS unsigned*)(lds + DA_VOFF + (slot) * DA_VS + wave * 1024), 16, 0, 0); \
                                __builtin_amdgcn_global_load_lds((const GAS unsigned*)(srcv + (size_t)(cc) * 8192 + 4096), (LAS unsigned*)(lds + DA_VOFF + (slot) * DA_VS + 8192 + wave * 1024), 16, 0, 0); } while (0)
            DA_DMA_K(0, 0); DA_DMA_K(1, 1); DA_DMA_V(0, 0);
            asm volatile("s_waitcnt vmcnt(0)" ::: "memory");
            __syncthreads();
            float m = 0.f, l = 0.f; f32x16 o0 = {}, o1 = {}, o2 = {}, o3 = {}; const f32x16 zero16 = {};
            const int qlim = wave * 32 + r;
            f32x16 sa0 = {}, sa1 = {}, sb0, sb1;
            {
                const LAS unsigned char* kb = lds + DA_KOFF + lane * 16;
#pragma unroll
                for (int ks = 0; ks < 4; ++ks) { sa0 = MFMA32(*(const LAS bf16x8*)(kb + ks * 1024), qf[ks], sa0); sa1 = MFMA32(*(const LAS bf16x8*)(kb + (4 + ks) * 1024), qf[ks], sa1); }
            }
            int kslot = 1, vslot = 0;
#pragma unroll 1
            for (int c = 0; c < nc; ++c) {
                const int ks2 = (kslot == 2) ? 0 : kslot + 1;
                if (c + 2 < nc) DA_DMA_K(c + 2, ks2);
                if (c + 1 < nc) DA_DMA_V(c + 1, vslot ^ 1);
                if (c < nact) {
                    const bool nxt = c + 1 < nact;
                    const LAS unsigned char* kb = lds + DA_KOFF + kslot * DA_KS + lane * 16;
                    const LAS unsigned char* vbp = lds + DA_VOFF + vslot * DA_VS + lane * 16;
                    bf16x8 kfr[8], va[4], vn[4];
                    const int cd = c - (nc - 4);
                    if (cd >= 0) {
#pragma unroll
                        for (int i = 0; i < 16; ++i) { const int key = cd * 64 + crow(i, hh); if (key > qlim) sa0[i] = -INFINITY; if (key + 32 > qlim) sa1[i] = -INFINITY; }
                    }
                    float rm = fmaxf(sa0[0], sa1[0]);
#pragma unroll
                    for (int i = 1; i < 16; ++i) rm = fmaxf(rm, fmaxf(sa0[i], sa1[i]));
                    rm -= m;
                    if (c == 0 || __any(rm > DA_THR)) {
                        rm = fmaxf(rm, __shfl_xor(rm, 32));
                        const float dl = (c == 0) ? rm : fmaxf(rm, 0.f), alpha = __builtin_amdgcn_exp2f(-dl);
                        m += dl; l *= alpha;
                        if (c > 0) {
                            sc[r] = alpha;
#pragma unroll
                            for (int g = 0; g < 4; ++g) { const f32x4 a = *(const LAS f32x4*)(sc + 8 * g + 4 * hh);
#pragma unroll
                                for (int e = 0; e < 4; ++e) { o0[4 * g + e] *= a[e]; o1[4 * g + e] *= a[e]; o2[4 * g + e] *= a[e]; o3[4 * g + e] *= a[e]; } }
                        }
                    }
                    if (nxt) {
#pragma unroll
                        for (int f = 0; f < 8; ++f) kfr[f] = *(const LAS bf16x8*)(kb + f * 1024);
                        __builtin_amdgcn_sched_barrier(0);
                        sb0 = MFMA32(kfr[0], qf[0], zero16); sb1 = MFMA32(kfr[4], qf[0], zero16);
#pragma unroll
                        for (int ks = 1; ks < 4; ++ks) { sb0 = MFMA32(kfr[ks], qf[ks], sb0); sb1 = MFMA32(kfr[4 + ks], qf[ks], sb1); }
                    }
#pragma unroll
                    for (int f = 0; f < 4; ++f) va[f] = *(const LAS bf16x8*)(vbp + f * 1024);
                    __builtin_amdgcn_sched_barrier(0);
                    float sum = 0.f;
#pragma unroll
                    for (int i = 0; i < 16; ++i) { sa0[i] = __builtin_amdgcn_exp2f(sa0[i] - m); sa1[i] = __builtin_amdgcn_exp2f(sa1[i] - m); sum += sa0[i] + sa1[i]; }
                    l += sum;
#pragma unroll
                    for (int g = 0; g < 4; ++g) {
                        if (g < 3) {
#pragma unroll
                            for (int f = 0; f < 4; ++f) vn[f] = *(const LAS bf16x8*)(vbp + ((g + 1) * 4 + f) * 1024);
                            __builtin_amdgcn_sched_barrier(0);
                        }
                        const int s = g & 1;
                        u32x4 w;
#pragma unroll
                        for (int e = 0; e < 4; ++e) w[e] = (g >> 1) ? cvtpk(sa1[8 * s + 2 * e], sa1[8 * s + 2 * e + 1]) : cvtpk(sa0[8 * s + 2 * e], sa0[8 * s + 2 * e + 1]);
                        const bf16x8 pa = __builtin_bit_cast(bf16x8, w);
                        o0 = MFMA32(pa, va[0], o0); o1 = MFMA32(pa, va[1], o1); o2 = MFMA32(pa, va[2], o2); o3 = MFMA32(pa, va[3], o3);
#pragma unroll
                        for (int f = 0; f < 4; ++f) va[f] = vn[f];
                    }
                    sa0 = sb0; sa1 = sb1;
                }
                kslot = ks2; vslot ^= 1;
                asm volatile("s_waitcnt vmcnt(0)" ::: "memory");
                __syncthreads();
            }
#undef DA_DMA_K
#undef DA_DMA_V
            l += __shfl_xor(l, 32);
            sc[r] = 1.0f / l;
#pragma unroll
            for (int g = 0; g < 4; ++g) { const f32x4 a = *(const LAS f32x4*)(sc + 8 * g + 4 * hh);
#pragma unroll
                for (int e = 0; e < 4; ++e) { const int i = 4 * g + e; bf16_t* p = O + (tok0 + crow(i, hh)) * 1536 + vh * 128 + r;
                    p[0] = (bf16_t)f2bf(o0[i] * a[e]); p[32] = (bf16_t)f2bf(o1[i] * a[e]); p[64] = (bf16_t)f2bf(o2[i] * a[e]); p[96] = (bf16_t)f2bf(o3[i] * a[e]); } }
        }
    }
    __builtin_amdgcn_s_setprio(0);
}
constexpr size_t WS_GCNT = 896 * 1024;
constexpr size_t WS_ML = 448 * MiB, WS_GLIST = 462 * MiB;
constexpr size_t OPART_BYTES = (size_t)48 * 8192 * 64 * 2;
__device__ __forceinline__ void moba_gate_phase(const bf16_t* Q, const float* kms, int* gcnt, unsigned short* glist, LAS unsigned char* lds, int tid) {
    const int lane = tid & 63, wave = __builtin_amdgcn_readfirstlane(tid >> 6), r = lane & 31, hh = lane >> 5;
    LAS int* cnt = (LAS int*)(lds + wave * 512); LAS int* gb = cnt + 32;
    const int gw = blockIdx.x * NWAVES + wave, ngw = gridDim.x * NWAVES;
    for (int wu = gw; wu < 48 * 31 * 8; wu += ngw) {
        const int u = wu >> 3, w8 = wu & 7;
        const int cur = 31 - u / 48, bh = u % 48, b = bh / 12, h = bh % 12;
        const size_t tok0 = (size_t)b * SEQ + cur * 256 + w8 * 32;
        if (lane < 32) cnt[lane] = 0;
        bf16x8 qf[4];
#pragma unroll
        for (int ks = 0; ks < 4; ++ks) qf[ks] = *(const bf16x8*)(Q + (tok0 + r) * 768 + h * 64 + ks * 16 + hh * 8);
        f32x16 ga = {};
        const float* kr = kms + ((size_t)(bh * 32 + r)) * 64 + hh * 8;
#pragma unroll
        for (int ks = 0; ks < 4; ++ks) { const f32x4 x0 = *(const f32x4*)(kr + ks * 16), x1 = *(const f32x4*)(kr + ks * 16 + 4);
            u32x4 hi, lo;
#pragma unroll
            for (int e = 0; e < 2; ++e) { const float a0 = x0[2 * e], a1 = x0[2 * e + 1], b0 = x1[2 * e], b1 = x1[2 * e + 1];
                hi[e] = cvtpk(a0, a1); hi[2 + e] = cvtpk(b0, b1);
                lo[e] = cvtpk(a0 - bf2f(hi[e] & 0xffffu), a1 - bf2f(hi[e] >> 16)); lo[2 + e] = cvtpk(b0 - bf2f(hi[2 + e] & 0xffffu), b1 - bf2f(hi[2 + e] >> 16)); }
            ga = MFMA32(__builtin_bit_cast(bf16x8, hi), qf[ks], ga); ga = MFMA32(__builtin_bit_cast(bf16x8, lo), qf[ks], ga); }
        float v0 = -INFINITY, v1 = -INFINITY, v2 = -INFINITY; int i0 = -1, i1 = -1, i2 = -1;
#pragma unroll
        for (int i = 0; i < 16; ++i) { const int j = crow(i, hh); const float g = (j < cur) ? ga[i] : -INFINITY; TOP3_INSERT(g, j); }
        const float p0 = __shfl_xor(v0, 32), p1 = __shfl_xor(v1, 32), p2 = __shfl_xor(v2, 32); const int q0 = __shfl_xor(i0, 32), q1 = __shfl_xor(i1, 32), q2 = __shfl_xor(i2, 32);
        TOP3_INSERT(p0, q0); TOP3_INSERT(p1, q1); TOP3_INSERT(p2, q2);
        int pp0 = 0, pp1 = 0, pp2 = 0;
        if (hh == 0) { if (i0 >= 0) pp0 = atomicAdd((int*)&cnt[i0], 1); if (i1 >= 0) pp1 = atomicAdd((int*)&cnt[i1], 1); if (i2 >= 0) pp2 = atomicAdd((int*)&cnt[i2], 1); }
        if (lane < 32) { const int n = cnt[lane]; gb[lane] = n ? atomicAdd(gcnt + bh * 32 + lane, n) : 0; }
        if (hh == 0) { const int qpos = cur * 256 + w8 * 32 + r;
            if (i0 >= 0) glist[(size_t)(bh * 32 + i0) * 8192 + gb[i0] + pp0] = (unsigned short)(qpos | (0 << 13));
            if (i1 >= 0) glist[(size_t)(bh * 32 + i1) * 8192 + gb[i1] + pp1] = (unsigned short)(qpos | (1 << 13));
            if (i2 >= 0) glist[(size_t)(bh * 32 + i2) * 8192 + gb[i2] + pp2] = (unsigned short)(qpos | (2 << 13)); }
    }
}
__device__ __forceinline__ void flash_block_lds(const bf16x8 (&qf)[4], const LAS unsigned char* kb, const LAS unsigned char* vb, LAS float* sc, int lane, float& m, float& l, f32x16& o0, f32x16& o1,
                                                int nchunk, int qlim, bool masked) {
    const int hh = lane >> 5;
#pragma unroll 1
    for (int c = 0; c < nchunk; ++c) {
        const LAS unsigned char* kp = kb + c * 8192 + lane * 16; const LAS unsigned char* vp = vb + c * 8192 + lane * 16;
        f32x16 p0 = {}, p1 = {};
#pragma unroll
        for (int ks = 0; ks < 4; ++ks) { p0 = MFMA32(*(const LAS bf16x8*)(kp + ks * 1024), qf[ks], p0); p1 = MFMA32(*(const LAS bf16x8*)(kp + (4 + ks) * 1024), qf[ks], p1); }
        if (masked) { const int t0 = qlim - c * 64 - 4 * hh;
#pragma unroll
            for (int i = 0; i < 16; ++i) { const int kc = (i & 3) + 8 * (i >> 2); if (kc > t0) p0[i] = -INFINITY; if (kc + 32 > t0) p1[i] = -INFINITY; } }
        float rm = fmaxf(p0[0], p1[0]);
#pragma unroll
        for (int i = 1; i < 16; ++i) rm = fmaxf(rm, fmaxf(p0[i], p1[i]));
        if (c == 0) m = fmaxf(rm, __shfl_xor(rm, 32));
        else if (__any(rm - m > 8.0f)) {
            rm = fmaxf(rm, __shfl_xor(rm, 32));
            const float dl = fmaxf(rm - m, 0.f), alpha = __builtin_amdgcn_exp2f(-dl);
            m += dl; l *= alpha;
            sc[lane & 31] = alpha;
#pragma unroll
            for (int g = 0; g < 4; ++g) { const f32x4 a = *(const LAS f32x4*)(sc + 8 * g + 4 * hh);
#pragma unroll
                for (int e = 0; e < 4; ++e) { o0[4 * g + e] *= a[e]; o1[4 * g + e] *= a[e]; } }
        }
        float sum = 0.f;
#pragma unroll
        for (int i = 0; i < 16; ++i) { p0[i] = __builtin_amdgcn_exp2f(p0[i] - m); p1[i] = __builtin_amdgcn_exp2f(p1[i] - m); sum += p0[i] + p1[i]; }
        l += sum;
#pragma unroll
        for (int s = 0; s < 2; ++s) {
            u32x4 w0, w1;
#pragma unroll
            for (int e = 0; e < 4; ++e) { w0[e] = cvtpk(p0[8 * s + 2 * e], p0[8 * s + 2 * e + 1]); w1[e] = cvtpk(p1[8 * s + 2 * e], p1[8 * s + 2 * e + 1]); }
            const bf16x8 a0 = __builtin_bit_cast(bf16x8, w0), a1 = __builtin_bit_cast(bf16x8, w1);
            o0 = MFMA32(a0, *(const LAS bf16x8*)(vp + (s * 2 + 0) * 1024), o0); o1 = MFMA32(a0, *(const LAS bf16x8*)(vp + (s * 2 + 1) * 1024), o1);
            o0 = MFMA32(a1, *(const LAS bf16x8*)(vp + (4 + s * 2 + 0) * 1024), o0); o1 = MFMA32(a1, *(const LAS bf16x8*)(vp + (4 + s * 2 + 1) * 1024), o1);
        }
    }
}
__device__ __forceinline__ void flash_block_lds_all(const bf16x8 (&qf)[4], const LAS unsigned char* kb, const LAS unsigned char* vb, int lane, float& m, float& l, f32x16& o0, f32x16& o1) {
    const LAS unsigned char* kp = kb + lane * 16; const LAS unsigned char* vp = vb + lane * 16;
    f32x16 s[8];
#pragma unroll
    for (int t = 0; t < 8; ++t) { s[t] = (f32x16){};
#pragma unroll
        for (int ks = 0; ks < 4; ++ks) s[t] = MFMA32(*(const LAS bf16x8*)(kp + (t * 4 + ks) * 1024), qf[ks], s[t]); }
    float rm = s[0][0];
#pragma unroll
    for (int t = 0; t < 8; ++t)
#pragma unroll
        for (int i = 0; i < 16; ++i) rm = fmaxf(rm, s[t][i]);
    rm = fmaxf(rm, __shfl_xor(rm, 32));
    float sum = 0.f;
#pragma unroll
    for (int t = 0; t < 8; ++t)
#pragma unroll
        for (int i = 0; i < 16; ++i) { s[t][i] = __builtin_amdgcn_exp2f(s[t][i] - rm); sum += s[t][i]; }
    m = rm; l = sum;
#pragma unroll
    for (int t = 0; t < 8; ++t)
#pragma unroll
        for (int h2 = 0; h2 < 2; ++h2) {
            u32x4 w;
#pragma unroll
            for (int e = 0; e < 4; ++e) w[e] = cvtpk(s[t][8 * h2 + 2 * e], s[t][8 * h2 + 2 * e + 1]);
            const bf16x8 pa = __builtin_bit_cast(bf16x8, w);
            o0 = MFMA32(pa, *(const LAS bf16x8*)(vp + ((t * 2 + h2) * 2 + 0) * 1024), o0); o1 = MFMA32(pa, *(const LAS bf16x8*)(vp + ((t * 2 + h2) * 2 + 1) * 1024), o1);
        }
}
constexpr int KS_K = 0, KS_V = 32768, KS_SCR = 65536, KS_TILE = 65536 + 8 * 512;
__device__ __forceinline__ void moba_keyblock_phase(const bf16_t* Q, const bf16_t* Kf, const bf16_t* Vf, const int* gcnt, const unsigned short* glist,
                                                    bf16_t* op0, bf16_t* op1, bf16_t* op2, float* ml, bf16_t* att, LAS unsigned char* lds, int tid) {
    const int lane = tid & 63, wave = __builtin_amdgcn_readfirstlane(tid >> 6), r = lane & 31, hh = lane >> 5;
    LAS float* sc = (LAS float*)(lds + KS_SCR + wave * 512); LAS int* sci = (LAS int*)(sc + 32);
    for (int u = blockIdx.x; u < 48 * 32; u += gridDim.x) {
        const int j = u / 48, bh = u % 48, b = bh / 12, h = bh % 12;
        const int n = (j < 31) ? gcnt[bh * 32 + j] : 0;
        {
            const bf16_t* ks = Kf + (size_t)bh * (SEQ * 64) + (size_t)j * (256 * 64) + tid * 8; const bf16_t* vs = Vf + (size_t)bh * (SEQ * 64) + (size_t)j * (256 * 64) + tid * 8;
            u32x4 a[4], c[4];
#pragma unroll
            for (int i = 0; i < 4; ++i) { a[i] = *(const u32x4*)(ks + i * 4096); c[i] = *(const u32x4*)(vs + i * 4096); }
#pragma unroll
            for (int i = 0; i < 4; ++i) { *(LAS u32x4*)(lds + KS_K + (tid + 512 * i) * 16) = a[i]; *(LAS u32x4*)(lds + KS_V + (tid + 512 * i) * 16) = c[i]; }
        }
        __syncthreads();
        const unsigned short* gl = glist + (size_t)(bh * 32 + j) * 8192;
        const int nit = (n + 31) >> 5;
        LAS bf16_t* tile = (LAS bf16_t*)(lds + KS_TILE + wave * 4096);
        {
            const int qpos = j * 256 + wave * 32 + r;
            bf16x8 qo[4];
#pragma unroll
            for (int ks = 0; ks < 4; ++ks) qo[ks] = *(const bf16x8*)(Q + ((size_t)b * SEQ + qpos) * 768 + h * 64 + ks * 16 + hh * 8);
            float m = -INFINITY, l = 0.f; f32x16 o0 = {}, o1 = {};
            flash_block_lds(qo, lds + KS_K, lds + KS_V, sc, lane, m, l, o0, o1, (wave >> 1) + 1, wave * 32 + r, true);
            l += __shfl_xor(l, 32);
#pragma unroll
            for (int i = 0; i < 16; ++i) { const int row = crow(i, hh); tile[row * 64 + r] = (bf16_t)f2bf(o0[i]); tile[row * 64 + 32 + r] = (bf16_t)f2bf(o1[i]); }
#pragma unroll
            for (int q = 0; q < 4; ++q) { const int row = q * 8 + (lane >> 3), ch = lane & 7;
                *(u32x4*)(att + ((size_t)b * SEQ + j * 256 + wave * 32 + row) * 1024 + h * 64 + ch * 8) = *(const LAS u32x4*)(tile + row * 64 + ch * 8); }
            if (hh == 0) { float* pm = ml + ((size_t)3 * (48 * 8192) + (size_t)bh * 8192 + qpos) * 2; pm[0] = m; pm[1] = l; }
        }
        int e0 = 0, e1 = 0; bf16x8 qf[4];
        const int w0 = NWAVES - 1 - wave;
        if (w0 < nit) { const int p = w0 * 32 + r; e0 = gl[p < n ? p : n - 1];
#pragma unroll
            for (int ks = 0; ks < 4; ++ks) qf[ks] = *(const bf16x8*)(Q + ((size_t)b * SEQ + (e0 & 8191)) * 768 + h * 64 + ks * 16 + hh * 8); }
        if (w0 + NWAVES < nit) { const int p = (w0 + NWAVES) * 32 + r; e1 = gl[p < n ? p : n - 1]; }
        for (int it = w0; it < nit; it += NWAVES) {
            const bool valid = it * 32 + r < n; const int e = e0, qpos = e & 8191, slot = e >> 13;
            const bool more = it + NWAVES < nit;
            bf16x8 qn[4]; int e2 = 0;
            if (more) {
#pragma unroll
                for (int ks = 0; ks < 4; ++ks) qn[ks] = *(const bf16x8*)(Q + ((size_t)b * SEQ + (e1 & 8191)) * 768 + h * 64 + ks * 16 + hh * 8);
                if (it + 2 * NWAVES < nit) { const int p = (it + 2 * NWAVES) * 32 + r; e2 = gl[p < n ? p : n - 1]; }
            } else {
#pragma unroll
                for (int ks = 0; ks < 4; ++ks) qn[ks] = qf[ks];
            }
            float m = -INFINITY, l = 0.f; f32x16 o0 = {}, o1 = {};
            flash_block_lds_all(qf, lds + KS_K, lds + KS_V, lane, m, l, o0, o1);
            l += __shfl_xor(l, 32);
            sci[r] = valid ? e : -1;
#pragma unroll
            for (int i = 0; i < 16; ++i) { const int row = crow(i, hh); tile[row * 64 + r] = (bf16_t)f2bf(o0[i]); tile[row * 64 + 32 + r] = (bf16_t)f2bf(o1[i]); }
#pragma unroll
            for (int q = 0; q < 4; ++q) { const int row = q * 8 + (lane >> 3), ch = lane & 7; const int id = sci[row];
                const u32x4 v = *(const LAS u32x4*)(tile + row * 64 + ch * 8);
                if (id >= 0) { const int sl = id >> 13; bf16_t* base = sl == 0 ? op0 : (sl == 1 ? op1 : op2);
                    *(u32x4*)(base + ((size_t)bh * 8192 + (id & 8191)) * 64 + ch * 8) = v; } }
            if (valid && hh == 0) { float* pm = ml + ((size_t)slot * (48 * 8192) + (size_t)bh * 8192 + qpos) * 2; pm[0] = m; pm[1] = l; }
            e0 = e1; e1 = e2;
#pragma unroll
            for (int ks = 0; ks < 4; ++ks) qf[ks] = qn[ks];
        }
        __syncthreads();
    }
}
__device__ __forceinline__ void moba_merge_phase(const bf16_t* op0, const bf16_t* op1, const bf16_t* op2, const float* ml, bf16_t* att, int gw, int ngw, int lane) {
    typedef float f32x2m __attribute__((ext_vector_type(2)));
    for (int it = gw; it < 48 * 8192 / 32; it += ngw) {
        const int bh = it >> 8, q0 = (it & 255) * 32, b = bh / 12, h = bh % 12, cur = q0 >> 8, nv = cur < 3 ? cur : 3;
        u32x4 ov[4], pv[4][3]; f32x2m mo[4], mp[4][3];
#pragma unroll
        for (int q = 0; q < 4; ++q) { const int row = q * 8 + (lane >> 3), ch = lane & 7, qp = q0 + row; const size_t qrow = (size_t)bh * 8192 + qp;
            ov[q] = *(const u32x4*)(att + ((size_t)b * SEQ + qp) * 1024 + h * 64 + ch * 8);
            mo[q] = *(const f32x2m*)(ml + ((size_t)3 * (48 * 8192) + qrow) * 2);
#pragma unroll
            for (int k = 0; k < 3; ++k) { if (k < nv) { const bf16_t* ob = k == 0 ? op0 : (k == 1 ? op1 : op2); pv[q][k] = *(const u32x4*)(ob + qrow * 64 + ch * 8); mp[q][k] = *(const f32x2m*)(ml + ((size_t)k * (48 * 8192) + qrow) * 2); }
                                          else { pv[q][k] = (u32x4){0u, 0u, 0u, 0u}; mp[q][k] = (f32x2m){-INFINITY, 0.f}; } } }
#pragma unroll
        for (int q = 0; q < 4; ++q) { const int row = q * 8 + (lane >> 3), ch = lane & 7, qp = q0 + row;
            float M = mo[q][0];
#pragma unroll
            for (int k = 0; k < 3; ++k) M = fmaxf(M, mp[q][k][0]);
            const float wo = __builtin_amdgcn_exp2f(mo[q][0] - M); float L = wo * mo[q][1], wk[3];
#pragma unroll
            for (int k = 0; k < 3; ++k) { wk[k] = (k < nv) ? __builtin_amdgcn_exp2f(mp[q][k][0] - M) : 0.f; L += wk[k] * mp[q][k][1]; }
            const float invL = 1.0f / L, ao = wo * invL;
            f32x4 x0, x1;
            x0[0] = bf2f(ov[q].x & 0xffffu) * ao; x0[1] = bf2f(ov[q].x >> 16) * ao; x0[2] = bf2f(ov[q].y & 0xffffu) * ao; x0[3] = bf2f(ov[q].y >> 16) * ao;
            x1[0] = bf2f(ov[q].z & 0xffffu) * ao; x1[1] = bf2f(ov[q].z >> 16) * ao; x1[2] = bf2f(ov[q].w & 0xffffu) * ao; x1[3] = bf2f(ov[q].w >> 16) * ao;
#pragma unroll
            for (int k = 0; k < 3; ++k) { const float a = wk[k] * invL; const u32x4 p = pv[q][k];
                x0[0] += bf2f(p.x & 0xffffu) * a; x0[1] += bf2f(p.x >> 16) * a; x0[2] += bf2f(p.y & 0xffffu) * a; x0[3] += bf2f(p.y >> 16) * a;
                x1[0] += bf2f(p.z & 0xffffu) * a; x1[1] += bf2f(p.z >> 16) * a; x1[2] += bf2f(p.w & 0xffffu) * a; x1[3] += bf2f(p.w >> 16) * a; }
            u32x4 o; o.x = cvtpk(x0[0], x0[1]); o.y = cvtpk(x0[2], x0[3]); o.z = cvtpk(x1[0], x1[1]); o.w = cvtpk(x1[2], x1[3]);
            *(u32x4*)(att + ((size_t)b * SEQ + qp) * 1024 + h * 64 + ch * 8) = o; }
    }
}
__device__ __forceinline__ void mem_attn_lds_phase(const bf16_t* QM, const bf16_t* MK, const bf16_t* MV, bf16_t* att, LAS unsigned char* lds, int tid) {
    const int lane = tid & 63, wave = __builtin_amdgcn_readfirstlane(tid >> 6), r = lane & 31, hh = lane >> 5;
    LAS float* sc = (LAS float*)(lds + KS_SCR + wave * 512); LAS bf16_t* tile = (LAS bf16_t*)(lds + KS_TILE + wave * 4096);
    for (int u = blockIdx.x; u < 256; u += gridDim.x) {
        const int bhd = u >> 4, b = bhd >> 2, head = bhd & 3, part = u & 15;
        {   const bf16_t* ks = MK + (size_t)bhd * (256 * 64) + tid * 8; const bf16_t* vs = MV + (size_t)bhd * (256 * 64) + tid * 8;
            u32x4 a[4], c[4];
#pragma unroll
            for (int i = 0; i < 4; ++i) { a[i] = *(const u32x4*)(ks + i * 4096); c[i] = *(const u32x4*)(vs + i * 4096); }
#pragma unroll
            for (int i = 0; i < 4; ++i) { *(LAS u32x4*)(lds + KS_K + (tid + 512 * i) * 16) = a[i]; *(LAS u32x4*)(lds + KS_V + (tid + 512 * i) * 16) = c[i]; }
        }
        __syncthreads();
#pragma unroll 1
        for (int k = 0; k < 2; ++k) {
            const size_t row0 = (size_t)b * SEQ + (size_t)(part * 16 + k * 8 + wave) * 32;
            bf16x8 qf[4];
#pragma unroll
            for (int ks = 0; ks < 4; ++ks) qf[ks] = *(const bf16x8*)(QM + (row0 + r) * 256 + head * 64 + ks * 16 + hh * 8);
            float m = -INFINITY, l = 0.f; f32x16 o0 = {}, o1 = {};
            flash_block_lds_all(qf, lds + KS_K, lds + KS_V, lane, m, l, o0, o1);
            l += __shfl_xor(l, 32);
            sc[r] = 1.0f / l;
#pragma unroll
            for (int g = 0; g < 4; ++g) { const f32x4 a = *(const LAS f32x4*)(sc + 8 * g + 4 * hh);
#pragma unroll
                for (int e = 0; e < 4; ++e) { const int i = 4 * g + e, row = crow(i, hh); tile[row * 64 + r] = (bf16_t)f2bf(o0[i] * a[e]); tile[row * 64 + 32 + r] = (bf16_t)f2bf(o1[i] * a[e]); } }
#pragma unroll
            for (int q = 0; q < 4; ++q) { const int row = q * 8 + (lane >> 3), ch = lane & 7;
                *(u32x4*)(att + (row0 + row) * 1024 + 768 + head * 64 + ch * 8) = *(const LAS u32x4*)(tile + row * 64 + ch * 8); }
        }
        __syncthreads();
    }
}
#define XB_TMO      128
#define XB_XCNT(j)  (256  + 64 * (j))
#define XB_XSUB(j)  (1280 + 64 * (j))
#define XB_XGEN(j)  (2304 + 64 * (j))
#define XB_TOP      3328
#define XB_TOPGEN   3392
#define XCD_BAR_WORDS 3456
#define XB_SPIN_CAP (1u << 18)

__device__ __forceinline__ unsigned xb_ld(unsigned* p)              { return __hip_atomic_load(p, __ATOMIC_RELAXED, __HIP_MEMORY_SCOPE_AGENT); }
__device__ __forceinline__ unsigned xb_add(unsigned* p, unsigned v) { return __hip_atomic_fetch_add(p, v, __ATOMIC_RELAXED, __HIP_MEMORY_SCOPE_AGENT); }
__device__ __forceinline__ unsigned xb_xcc_id() { return (unsigned)__builtin_amdgcn_s_getreg((3 << 11) | 20) & 0xFu; }
#define XB_SPIN(cond, bar) do { unsigned _sp = 0; while (cond) { __builtin_amdgcn_s_sleep(1); \
    if ((++_sp & 255u) == 0u) { if (xb_ld(&(bar)[XB_TMO])) break; if (_sp > XB_SPIN_CAP) { atomicAdd(&(bar)[XB_TMO], 1u); break; } } } } while (0)

struct XcdBarrier {
    unsigned* bar; unsigned x;
    volatile LAS unsigned* st;
};

__device__ __forceinline__ XcdBarrier xcd_barrier_post(unsigned* bar, volatile LAS unsigned* st) {
    XcdBarrier b; b.bar = bar; b.x = xb_xcc_id(); b.st = st;
    if (threadIdx.x == 0) (void)xb_add(&bar[XB_XCNT(b.x)], 1u);
    return b;
}
__device__ __forceinline__ void xcd_barrier_complete(unsigned* bar, unsigned x, unsigned& nloc, unsigned& nx) {
    const unsigned G = gridDim.x * gridDim.y * gridDim.z;
    unsigned sum, cnt, mine, sp = 0u;
    for (;;) {
        sum = 0u; cnt = 0u; mine = 0u;
#pragma unroll
        for (unsigned j = 0; j < 16; ++j) { const unsigned c = xb_ld(&bar[XB_XCNT(j)]); sum += c; cnt += (c > 0u) ? 1u : 0u; mine = (j == x) ? c : mine; }
        if (sum == G) break;
        __builtin_amdgcn_s_sleep(1);
        if ((++sp & 255u) == 0u) { if (xb_ld(&bar[XB_TMO])) break; if (sp > XB_SPIN_CAP) { atomicAdd(&bar[XB_TMO], 1u); break; } }
    }
    nloc = mine > 0u ? mine : 1u; nx = cnt > 0u ? cnt : 1u;
}

__device__ __forceinline__ void xcd_barrier(const XcdBarrier& b) {
    asm volatile("s_waitcnt vmcnt(0)" ::: "memory");
    __syncthreads();
    if (threadIdx.x == 0) {
        unsigned* bar = b.bar;
        __builtin_amdgcn_s_waitcnt(0);
        unsigned nloc = b.st[0], nx = b.st[1];
        if (nloc == 0u) { xcd_barrier_complete(bar, b.x, nloc, nx); b.st[0] = nloc; b.st[1] = nx; }
        const unsigned old = xb_add(&bar[XB_XSUB(b.x)], 1u);
        const unsigned gen = old / nloc;
        if (old + 1u == (gen + 1u) * nloc) {
            __builtin_amdgcn_fence(__ATOMIC_RELEASE, "agent");
            asm volatile("s_waitcnt vmcnt(0)" ::: "memory");
            const unsigned og = xb_add(&bar[XB_TOP], 1u);
            const unsigned tg = og / nx;
            if (og + 1u == (tg + 1u) * nx) xb_add(&bar[XB_TOPGEN], 1u);
            else XB_SPIN(xb_ld(&bar[XB_TOPGEN]) == tg, bar);
            __builtin_amdgcn_fence(__ATOMIC_ACQUIRE, "agent");
            xb_add(&bar[XB_XGEN(b.x)], 1u);
            asm volatile("s_waitcnt vmcnt(0)" ::: "memory");
        } else {
            XB_SPIN(xb_ld(&bar[XB_XGEN(b.x)]) == gen, bar);
            __builtin_amdgcn_fence(__ATOMIC_ACQUIRE, "agent");
            asm volatile("s_waitcnt vmcnt(0)" ::: "memory");
        }
    }
    __syncthreads();
}

#define CONVERT_WEIGHTS(IT_LO, IT_HI) do { \
        LAS float* scr = (LAS float*)(L + wave * 16384); \
        LAS unsigned long long* T = (LAS unsigned long long*)(L + 132096); \
        _Pragma("unroll") \
        for (int k = 0; k < NWD; ++k) if (tid == k) { T[k * 8 + 0] = (unsigned long long)P.wd[k].src; T[k * 8 + 1] = (unsigned long long)P.wd[k].gain; T[k * 8 + 2] = (unsigned long long)P.wd[k].dst; \
            T[k * 8 + 3] = (unsigned)P.wd[k].K | ((unsigned long long)(unsigned)P.wd[k].N << 32); T[k * 8 + 4] = (unsigned)P.wd[k].col0 | ((unsigned long long)(unsigned)P.wd[k].ncols << 32); \
            T[k * 8 + 5] = (unsigned)P.wd[k].rowoff | ((unsigned long long)(unsigned)P.wd[k].perm << 32); T[k * 8 + 6] = (unsigned)P.wd[k].start; } \
        __syncthreads(); \
        for (int it = IT_LO + gw; it < IT_HI; it += ngw) { \
            int k = 0; \
            for (int j = 1; j < NWD; ++j) if (it >= (int)(unsigned)T[j * 8 + 6]) k = j; \
            k = __builtin_amdgcn_readfirstlane(k); \
            WDesc w; w.src = (const float*)(GAS const float*)rfl64(T[k * 8 + 0]); w.gain = (const float*)(GAS const float*)rfl64(T[k * 8 + 1]); w.dst = (bf16_t*)(GAS bf16_t*)rfl64(T[k * 8 + 2]); \
            { const unsigned long long a = rfl64(T[k * 8 + 3]), b = rfl64(T[k * 8 + 4]), c = rfl64(T[k * 8 + 5]), d = rfl64(T[k * 8 + 6]); \
              w.K = (int)(unsigned)a; w.N = (int)(a >> 32); w.col0 = (int)(unsigned)b; w.ncols = (int)(b >> 32); w.rowoff = (int)(unsigned)c; w.perm = (int)(c >> 32); w.start = (int)(unsigned)d; w.pad = 0; } \
            p0_transpose_item(w, scr, it - w.start, lane); \
        } \
        __syncthreads(); \
    } while (0)
__global__ void __launch_bounds__(NTHREADS, 2) fwd_kernel(Params P) {
    extern __shared__ __attribute__((aligned(16))) unsigned char lds[];
    cg::grid_group grid = cg::this_grid();
    LAS unsigned char* L = (LAS unsigned char*)lds;
    volatile LAS unsigned* bst = (volatile LAS unsigned*)(L + LDS_BYTES - 64);
    if (threadIdx.x < 2) bst[threadIdx.x] = 0u;
    __syncthreads();
    const XcdBarrier xbar = xcd_barrier_post((unsigned*)(P.ws + WS_BAR), bst);
#ifdef PROBE_K
#define STAMP(k) do { if (bx == 0 && tid == 0) ((unsigned long long*)(ws + WS_SS0 + 256 * 1024))[k] = __builtin_amdgcn_s_memrealtime(); } while (0)
#else
#define STAMP(k) do { } while (0)
#endif
#define PHASE_PTRS \
    int tid = threadIdx.x; asm volatile("" : "+v"(tid)); const int lane = tid & 63, wave = __builtin_amdgcn_readfirstlane(tid >> 6); \
    const int G = gridDim.x, bx = blockIdx.x, gw = bx * NWAVES + wave, ngw = G * NWAVES, gtid = bx * NTHREADS + tid, nthr = G * NTHREADS; \
    (void)lane; (void)gw; (void)ngw; (void)gtid; (void)nthr; \
    GAS unsigned char* wsg_; { GAS unsigned char* t_ = (GAS unsigned char*)rfl64((unsigned long long)P.ws); asm volatile("" : "=s"(wsg_) : "0"(t_)); } unsigned char* ws = (unsigned char*)wsg_; \
    float* ss1 = (float*)(ws + WS_SS); float* ss2 = ss1 + MTOK; float* ss3 = ss2 + MTOK; float* ss4 = ss3 + MTOK; (void)ss1; (void)ss2; (void)ss3; (void)ss4; \
    float* kms = (float*)(ws + WS_KMS); float* ss0 = (float*)(ws + WS_SS0); float* ssm = (float*)(ws + WS_SSM); (void)kms; (void)ss0; (void)ssm; \
    float* cosT = (float*)(ws + WS_COS); float* sinT = (float*)(ws + WS_SIN); (void)cosT; (void)sinT; \
    bf16_t* WA_in = (bf16_t*)(ws + WS_WA_IN); bf16_t* WA_v = (bf16_t*)(ws + WS_WA_V); (void)WA_v; bf16_t* WA_out = (bf16_t*)(ws + WS_WA_OUT); bf16_t* WA_up = (bf16_t*)(ws + WS_WA_UP); bf16_t* WA_down = (bf16_t*)(ws + WS_WA_DOWN); \
    bf16_t* WB_in = (bf16_t*)(ws + WS_WB_IN); bf16_t* WB_v = (bf16_t*)(ws + WS_WB_V); bf16_t* WB_out = (bf16_t*)(ws + WS_WB_OUT); bf16_t* WB_up = (bf16_t*)(ws + WS_WB_UP); bf16_t* WB_down = (bf16_t*)(ws + WS_WB_DOWN); \
    bf16_t* WA_mem = (bf16_t*)(ws + WS_WA_MEM); bf16_t* WB_mem = (bf16_t*)(ws + WS_WB_MEM); bf16_t* mem16 = (bf16_t*)(ws + WS_MEM16); \
    bf16_t* MKA = (bf16_t*)(ws + WS_MKA); bf16_t* MVA = (bf16_t*)(ws + WS_MVA); bf16_t* MKB = (bf16_t*)(ws + WS_MKB); bf16_t* MVB = (bf16_t*)(ws + WS_MVB); \
    bf16_t* x16 = (bf16_t*)(ws + WS_X16); bf16_t* att = (bf16_t*)(ws + WS_ATT); unsigned char* big = ws + WS_BIG; \
    bf16_t* QA = (bf16_t*)(big + BG_QA); bf16_t* KA = (bf16_t*)(big + BG_KA); bf16_t* VA = (bf16_t*)(big + BG_VA); bf16_t* OA = (bf16_t*)(big + BG_OA); bf16_t* QMA = (bf16_t*)(big + BG_QMA); \
    bf16_t* QB = (bf16_t*)(big + BG_QB); bf16_t* KBf = (bf16_t*)(big + BG_KB); bf16_t* VBf = (bf16_t*)(big + BG_VB); bf16_t* QMB = (bf16_t*)(big + BG_QMB); bf16_t* H = (bf16_t*)big; \
    (void)WA_in; (void)WA_out; (void)WA_up; (void)WA_down; (void)WB_in; (void)WB_v; (void)WB_out; (void)WB_up; (void)WB_down; (void)WA_mem; (void)WB_mem; (void)mem16; (void)MKA; (void)MVA; (void)MKB; (void)MVB; \
    (void)x16; (void)att; (void)QA; (void)KA; (void)VA; (void)OA; (void)QMA; (void)QB; (void)KBf; (void)VBf; (void)QMB; (void)H; \
    LAS float* wsc = (LAS float*)(L + wave * 512); (void)wsc;

    { PHASE_PTRS STAMP(0);
        for (int i = gtid; i < 57344 + 384; i += nthr) ((u32x4*)ws)[i] = (u32x4){0u, 0u, 0u, 0u};
        { float myinv = 0.f;
#pragma unroll
            for (int d = 0; d < 32; ++d) myinv = ((lane & 31) == d) ? P.inv[d] : myinv;
            for (int e = gtid; e < SEQ * 32; e += nthr) { float s, c; sincos_acc((float)(e >> 5) * myinv, s, c); cosT[e] = c; sinT[e] = s; } }
        for (int m = gw; m + 3 * ngw < MTOK; m += 4 * ngw) rows_to_bf16<4>(P.x + (size_t)m * DM, x16 + (size_t)m * DM, ss0 + m, (size_t)ngw, lane);
        for (int m = gw; m < MEMROWS; m += ngw) rows_to_bf16<1>(P.mem + (size_t)m * DM, mem16 + (size_t)m * DM, ssm + m, 0, lane);
        CONVERT_WEIGHTS(0, P.nearly);
    }
    if (P.nitems == 0x7fffffff) grid.sync();
    xcd_barrier(xbar);
    { PHASE_PTRS STAMP(1);
        { pg8::Gemm g{x16, WA_in, MTOK, 1792, DM}; pg8::StaticOrder S; S.init(MTOK, 1792, G, bx);
          pg8::EpiInB E{KA, QA, QMA, nullptr, ss0, cosT, sinT, C2}; pg8::gemm_phase<pg8::EpiInB, pg8::StaticOrder, true, true>(L, g, S, E); }
        { pg8::Gemm g{WA_v, x16, 768, MTOK, DM}; pg8::StaticOrder S; S.init(768, MTOK, G, (bx + G / 2) % G);
          pg8::EpiVt<13, 6, 7> E{VA, ss0}; pg8::gemm_phase<pg8::EpiVt<13, 6, 7>, pg8::StaticOrder, true, true>(L, g, S, E); }
        { pg8::Gemm g{mem16, WA_mem, MEMROWS, 256, DM}; pg8::StaticOrder S; S.init(MEMROWS, 256, G, bx);
          pg8::EpiMemK E{MKA, ssm}; pg8::gemm_phase<pg8::EpiMemK, pg8::StaticOrder, true, true>(L, g, S, E); }
        { pg8::Gemm g{mem16, WB_mem, MEMROWS, 256, DM}; pg8::StaticOrder S; S.init(MEMROWS, 256, G, (bx + G - 4) % G);
          pg8::EpiMemK E{MKB, ssm}; pg8::gemm_phase<pg8::EpiMemK, pg8::StaticOrder, true, true>(L, g, S, E); }
        { pg8::Gemm g{WA_mem + 256 * DM, mem16, 256, MEMROWS, DM}; pg8::StaticOrder S; S.init(256, MEMROWS, G, (bx + G - 8) % G);
          pg8::EpiVt<8, 4, 6> E{MVA, ssm}; pg8::gemm_phase<pg8::EpiVt<8, 4, 6>, pg8::StaticOrder, true, true>(L, g, S, E); }
        { pg8::Gemm g{WB_mem + 256 * DM, mem16, 256, MEMROWS, DM}; pg8::StaticOrder S; S.init(256, MEMROWS, G, (bx + G - 12) % G);
          pg8::EpiVt<8, 4, 6> E{MVB, ssm}; pg8::gemm_phase<pg8::EpiVt<8, 4, 6>, pg8::StaticOrder, true, true>(L, g, S, E); }
    }
    xcd_barrier(xbar);
    { PHASE_PTRS STAMP(2);
        mem_attn_lds_phase(QMA, MKA, MVA, att, L, tid);
        __syncthreads();
        diff_attn_phase(QA, KA, VA, OA, L, tid);
        __syncthreads();
    }
    { PHASE_PTRS CONVERT_WEIGHTS(P.nearly, P.nitems); }
    xcd_barrier(xbar);
    { PHASE_PTRS STAMP(3); diff_combine_phase(OA, P.a_lambda, P.a_subln, att, gw, ngw, lane); }
    xcd_barrier(xbar);
    { PHASE_PTRS STAMP(4); pg8::Gemm g{att, WA_out, MTOK, DM, DM}; pg8::StaticOrder S; S.init(MTOK, DM, G, bx);
      pg8::EpiRes<true, false> E{P.x, x16, ss1, nullptr}; pg8::gemm_phase<pg8::EpiRes<true, false>, pg8::StaticOrder, true, true>(L, g, S, E); }
    xcd_barrier(xbar);
    { PHASE_PTRS STAMP(5); pg8::Gemm g{x16, WA_up, MTOK, FF, DM}; pg8::StaticOrder S; S.init(MTOK, FF, G, bx);
      pg8::EpiUp E{H}; pg8::gemm_phase<pg8::EpiUp, pg8::StaticOrder, true, true>(L, g, S, E); }
    xcd_barrier(xbar);
    { PHASE_PTRS STAMP(6); pg8::Gemm g{H, WA_down, MTOK, DM, FF}; pg8::StaticOrder S; S.init(MTOK, DM, G, bx);
      pg8::EpiRes<false, true> E{nullptr, x16, ss2, ss1}; pg8::gemm_phase<pg8::EpiRes<false, true>, pg8::StaticOrder, true, true>(L, g, S, E); }
    xcd_barrier(xbar);
    { PHASE_PTRS STAMP(7);
        { pg8::Gemm g{x16, WB_in, MTOK, 1792, DM}; pg8::StaticOrder S; S.init(MTOK, 1792, G, bx);
          pg8::EpiInB E{KBf, QB, QMB, kms, ss2, cosT, sinT, C2}; pg8::gemm_phase<pg8::EpiInB, pg8::StaticOrder, true, true>(L, g, S, E); }
        { pg8::Gemm g{WB_v, x16, 768, MTOK, DM}; pg8::StaticOrder S; S.init(768, MTOK, G, (bx + G / 2) % G);
          pg8::EpiVt<13, 12, 6> E{VBf, ss2}; pg8::gemm_phase<pg8::EpiVt<13, 12, 6>, pg8::StaticOrder, true, true>(L, g, S, E); }
    }
    xcd_barrier(xbar);
    { PHASE_PTRS STAMP(8);
        mem_attn_lds_phase(QMB, MKB, MVB, att, L, tid);
        __syncthreads();
        moba_gate_phase(QB, kms, (int*)(ws + WS_GCNT), (unsigned short*)(ws + WS_GLIST), L, tid);
    }
    xcd_barrier(xbar);
    { PHASE_PTRS STAMP(13);
        bf16_t* op0 = (bf16_t*)P.out; bf16_t* op1 = (bf16_t*)((unsigned char*)P.out + OPART_BYTES); bf16_t* op2 = (bf16_t*)(big + 160 * MiB);
        moba_keyblock_phase(QB, KBf, VBf, (const int*)(ws + WS_GCNT), (const unsigned short*)(ws + WS_GLIST), op0, op1, op2, (float*)(ws + WS_ML), att, L, tid);
    }
    xcd_barrier(xbar);
    { PHASE_PTRS STAMP(14);
        const bf16_t* op0 = (const bf16_t*)P.out; const bf16_t* op1 = (const bf16_t*)((const unsigned char*)P.out + OPART_BYTES); const bf16_t* op2 = (const bf16_t*)(big + 160 * MiB);
        moba_merge_phase(op0, op1, op2, (const float*)(ws + WS_ML), att, gw, ngw, lane);
    }
    xcd_barrier(xbar);
    { PHASE_PTRS STAMP(9); pg8::Gemm g{att, WB_out, MTOK, DM, DM}; pg8::StaticOrder S; S.init(MTOK, DM, G, bx);
      pg8::EpiRes<false, false> E{nullptr, x16, ss3, nullptr}; pg8::gemm_phase<pg8::EpiRes<false, false>, pg8::StaticOrder, true, true>(L, g, S, E); }
    xcd_barrier(xbar);
    { PHASE_PTRS STAMP(10); pg8::Gemm g{x16, WB_up, MTOK, FF, DM}; pg8::StaticOrder S; S.init(MTOK, FF, G, bx);
      pg8::EpiUp E{H}; pg8::gemm_phase<pg8::EpiUp, pg8::StaticOrder, true, true>(L, g, S, E); }
    xcd_barrier(xbar);
    { PHASE_PTRS STAMP(11); pg8::Gemm g{H, WB_down, MTOK, DM, FF}; pg8::StaticOrder S; S.init(MTOK, DM, G, bx);
      pg8::EpiRes<false, true> E{nullptr, x16, ss4, ss3}; pg8::gemm_phase<pg8::EpiRes<false, true>, pg8::StaticOrder, true, true>(L, g, S, E); }
    xcd_barrier(xbar);
    { PHASE_PTRS STAMP(12);
    for (int m0 = gw; m0 + 3 * ngw < MTOK; m0 += 4 * ngw) {
        u32x2 w[4][4]; float rs[4];
#pragma unroll
        for (int q = 0; q < 4; ++q) { const int m = m0 + q * ngw; rs[q] = rstd_of(ss4[m]); const u32x2* xb = (const u32x2*)(x16 + (size_t)m * DM) + lane;
#pragma unroll
            for (int j = 0; j < 4; ++j) w[q][j] = __builtin_nontemporal_load(xb + 64 * j); }
        const f32x4* gr = (const f32x4*)P.final_norm + lane;
#pragma unroll
        for (int q = 0; q < 4; ++q) { const int m = m0 + q * ngw; f32x4* xr = (f32x4*)(P.out + (size_t)m * DM) + lane;
#pragma unroll
            for (int j = 0; j < 4; ++j) { f32x4 v; v[0] = __builtin_bit_cast(float, w[q][j].x << 16); v[1] = __builtin_bit_cast(float, w[q][j].x & 0xffff0000u); v[2] = __builtin_bit_cast(float, w[q][j].y << 16); v[3] = __builtin_bit_cast(float, w[q][j].y & 0xffff0000u);
                v = v * rs[q] * gr[64 * j];
#ifdef PROBE_K
                if (m < 4096) { const unsigned long long* st = (const unsigned long long*)(ws + WS_SS0 + 256 * 1024);
                    const float f = (PROBE_K == 9999) ? 1.0f : (float)(st[PROBE_K % 100] - st[PROBE_K / 100]) / (float)(st[11] - st[0]); v = v + 0.04f * f; }
#endif
                xr[64 * j] = v; } }
    } }
}

extern "C" void kernel_launch(void* const* d_in, const int* in_sizes, int n_in, void* d_out, int out_size, void* d_ws, size_t ws_size, hipStream_t stream) {
    static int ready = 0;
    if (ready == 0) {
        ready = -1;
        if (n_in != 23 || in_sizes[0] != MTOK * DM || out_size != MTOK * DM || ws_size < WS_END) { fprintf(stderr, "kernel_launch: unexpected shapes / workspace (n_in %d, ws %zu)\n", n_in, ws_size); return; }
        if (hipFuncSetAttribute((const void*)fwd_kernel, hipFuncAttributeMaxDynamicSharedMemorySize, LDS_BYTES) != hipSuccess) { fprintf(stderr, "kernel_launch: hipFuncSetAttribute failed\n"); return; }
        ready = 1;
    }
    if (ready < 0) return;
    Params p{};
    p.x = (const float*)d_in[0]; p.mem = (const float*)d_in[1]; p.a_lambda = (const float*)d_in[4]; p.a_subln = (const float*)d_in[5]; p.final_norm = (const float*)d_in[22];
    p.out = (float*)d_out; p.ws = (unsigned char*)d_ws;
    unsigned char* ws = (unsigned char*)d_ws;
    auto F = [&](int i) { return (const float*)d_in[i]; };
    auto B = [&](size_t off) { return (bf16_t*)(ws + off); };
    const WDesc wd[NWD] = {
        {F(3),  F(2),  B(WS_WA_IN),   1024, 2560, 768,  768,  0,    1, 0, 0},
        {F(3),  F(2),  B(WS_WA_IN),   1024, 2560, 0,    768,  768,  1, 0, 0},
        {F(3),  F(2),  B(WS_WA_IN),   1024, 2560, 2304, 256,  1536, 0, 0, 0},
        {F(3),  F(2),  B(WS_WA_V),    1024, 2560, 1536, 768,  0,    0, 0, 0},
        {F(7),  F(6),  B(WS_WA_MEM),  1024, 512,  0,    512,  0,    0, 0, 0},
        {F(17), F(16), B(WS_WB_MEM),  1024, 512,  0,    512,  0,    0, 0, 0},
        {F(8),  nullptr, B(WS_WA_OUT), 1024, 1024, 0,   1024, 0,    0, 0, 0},
        {F(10), F(9),  B(WS_WA_UP),   1024, 4096, 0,    4096, 0,    0, 0, 0},
        {F(11), nullptr, B(WS_WA_DOWN), 4096, 1024, 0,  1024, 0,    0, 0, 0},
        {F(13), F(12), B(WS_WB_IN),   1024, 1536, 0,    768,  0,    1, 0, 0},
        {F(13), F(12), B(WS_WB_V),    1024, 1536, 768,  768,  0,    0, 0, 0},
        {F(15), F(14), B(WS_WB_IN),   1024, 1024, 0,    768,  768,  1, 0, 0},
        {F(15), F(14), B(WS_WB_IN),   1024, 1024, 768,  256,  1536, 0, 0, 0},
        {F(18), nullptr, B(WS_WB_OUT), 1024, 1024, 0,   1024, 0,    0, 0, 0},
        {F(20), F(19), B(WS_WB_UP),   1024, 4096, 0,    4096, 0,    0, 0, 0},
        {F(21), nullptr, B(WS_WB_DOWN), 4096, 1024, 0,  1024, 0,    0, 0, 0},
    };
    int start = 0;
    for (int k = 0; k < NWD; ++k) { p.wd[k] = wd[k]; p.wd[k].start = start; start += (wd[k].K / 64) * (wd[k].ncols / 32); }
    p.nitems = start;
    p.nearly = 0; for (int k = 0; k < 6; ++k) p.nearly += (wd[k].K / 64) * (wd[k].ncols / 32);
    for (int d = 0; d < 32; ++d) p.inv[d] = 1.0f / powf(10000.0f, (float)d / 32.0f);
    if (hipMemsetAsync((char*)d_ws + WS_BAR, 0, 16384, stream) != hipSuccess) { fprintf(stderr, "kernel_launch: hipMemsetAsync failed\n"); return; }
    void* args[] = {&p};
    const hipError_t e = hipLaunchCooperativeKernel((const void*)fwd_kernel, dim3(256), dim3(NTHREADS), args, LDS_BYTES, stream);
    if (e != hipSuccess) fprintf(stderr, "kernel_launch: cooperative launch failed: %s\n", hipGetErrorString(e));
}
```

```cpp
#include <hip/hip_runtime.h>
#include <hip/hip_cooperative_groups.h>
#include <cmath>
namespace cg = cooperative_groups;
#include <hip/hip_runtime.h>
#include <cstdio>
#include <cstdint>
namespace pg8 {
#define PG8_LAS __attribute__((address_space(3)))
typedef unsigned short bf16_t;
typedef short bf16x8 __attribute__((ext_vector_type(8)));
typedef float f32x4 __attribute__((ext_vector_type(4)));
typedef unsigned u32x4 __attribute__((ext_vector_type(4)));
constexpr int BM = 256, BK = 64, HALF = 128, HTB = HALF * BK * 2  , STAGE_BYTES = 8 * HTB, NXCD = 8, WGM = 8;

__host__ __device__ __forceinline__ int lds_byte(int r, int c) { const int st = (r >> 4) * 2 + (c >> 5), rr = r & 15, cc = c & 31, ob = rr * 64 + cc * 2; return st * 1024 + (ob ^ (((ob >> 9) & 1) << 5)); }
__host__ __device__ __forceinline__ void stage_rc(int b, int& R, int& C) { const int st = b / 1024, sb = b % 1024, swz = sb ^ (((sb >> 9) & 1) << 5); R = (st >> 1) * 16 + swz / 64; C = (st & 1) * 32 + (swz % 64) / 2; }
__host__ __device__ __forceinline__ int perm32(int rho) { const int n = rho >> 4, i = rho & 15; return 8 * (i >> 2) + 4 * n + (i & 3); }

struct Unit { int pm, pn; };
struct Gemm { const bf16_t* A; const bf16_t* Bt; int M, N, K; };

struct StaticOrder {
    int nM, nN, nwg, G, c;
    __host__ __device__ void init(int M, int N, int G_, int c_) { nM = M / BM; nN = N / BM; nwg = nM * nN; G = G_; c = c_; }
    __host__ __device__ bool next(int i, Unit& u) const {
        const long L = (long)i * G + c; if (L >= nwg) return false;
        int wgid = (int)L; { const int q = nwg / NXCD, r = nwg % NXCD, xcd = wgid % NXCD, off = wgid / NXCD; wgid = (xcd < r ? xcd * (q + 1) : r * (q + 1) + (xcd - r) * q) + off; }
        const int nig = WGM * nN, gid = wgid / nig, fm = gid * WGM, gsz = (nM - fm) < WGM ? (nM - fm) : WGM;
        u.pm = fm + ((wgid % nig) % gsz); u.pn = (wgid % nig) / gsz; return true;
    }
    __device__ __forceinline__ void a_ready(const Unit&) const {}
    __device__ __forceinline__ void done(const Unit&) const {}
};

typedef float f32x2_t __attribute__((ext_vector_type(2))); typedef __bf16 bf16x2_t __attribute__((ext_vector_type(2)));
typedef unsigned u32x2 __attribute__((ext_vector_type(2)));
__device__ __forceinline__ unsigned cvtpk(float lo, float hi) { f32x2_t v = {lo, hi}; bf16x2_t b = __builtin_convertvector(v, bf16x2_t); return __builtin_bit_cast(unsigned, b); }
__device__ __forceinline__ u32x2 pk4(const f32x4 v) { u32x2 w; w.x = cvtpk(v[0], v[1]); w.y = cvtpk(v[2], v[3]); return w; }
constexpr float RMS_EPS = 1e-6f;
__device__ __forceinline__ float rstd_of(float ss) { return 1.0f / sqrtf(ss * (1.0f / 1024.0f) + RMS_EPS); }

struct EpiInB {
    static constexpr bool PERM = false, AFTER_DRAIN = false;
    bf16_t *Kf, *Q, *QM; float* kms; const float* ss; const float* cs; const float* sn; float c2;
    __device__ __forceinline__ void operator()(const f32x4 (&acc)[2][2][4][2], const Unit& u, int wr, int wc, int fr, int fq) const {
        const int tile = u.pn, row0 = u.pm * BM + wr * 64 + fr;
        if (tile < 6) {
            const bool isk = tile < 3; const float sc = isk ? 1.f : c2; const int d1 = (wc & 1) * 16 + fq * 4;
            f32x4 cs1[2] = {{0.f, 0.f, 0.f, 0.f}, {0.f, 0.f, 0.f, 0.f}}, cs2[2] = {{0.f, 0.f, 0.f, 0.f}, {0.f, 0.f, 0.f, 0.f}};
#pragma unroll
            for (int ai = 0; ai < 2; ++ai)
#pragma unroll
                for (int m = 0; m < 4; ++m) { const int row = row0 + ai * HALF + m * 16, pos = row & 8191, b = row >> 13; const float rs = rstd_of(ss[row]) * sc;
                    const f32x4 c4 = *(const f32x4*)(cs + pos * 32 + d1), s4 = *(const f32x4*)(sn + pos * 32 + d1);
#pragma unroll
                    for (int bj = 0; bj < 2; ++bj) { const f32x4 x1 = acc[ai][bj][m][0] * rs, x2 = acc[ai][bj][m][1] * rs;
                        const f32x4 o1 = x1 * c4 - x2 * s4, o2 = x2 * c4 + x1 * s4;
                        const int hl = bj * 2 + (wc >> 1);
                        if (isk) { const int h = tile * 4 + hl; if (kms) { cs1[bj] += o1; cs2[bj] += o2; }
                            bf16_t* p = Kf + (size_t)(b * 12 + h) * (8192 * 64) + ((size_t)((pos >> 5) * 4 + (wc & 1)) * 64 + (fq >> 1) * 32 + (pos & 31)) * 8 + (fq & 1) * 4;
                            *(u32x2*)p = pk4(o1); *(u32x2*)(p + 2 * 512) = pk4(o2); }
                        else { bf16_t* p = Q + (size_t)row * 768 + (tile - 3) * 256 + hl * 64 + d1; *(u32x2*)p = pk4(o1); *(u32x2*)(p + 32) = pk4(o2); } } }
            if (isk && kms) {
                const int b = u.pm >> 5, blk = u.pm & 31;
#pragma unroll
                for (int bj = 0; bj < 2; ++bj)
#pragma unroll
                    for (int j = 0; j < 4; ++j) { float a = cs1[bj][j], c = cs2[bj][j];
#pragma unroll
                        for (int o = 1; o < 16; o <<= 1) { a += __shfl_xor(a, o); c += __shfl_xor(c, o); }
                        if (fr == 0) { const int h = tile * 4 + bj * 2 + (wc >> 1); float* p = kms + ((size_t)((b * 12 + h) * 32 + blk)) * 64 + d1 + j; atomicAdd(p, a); atomicAdd(p + 32, c); } }
            }
        } else {
#pragma unroll
            for (int ai = 0; ai < 2; ++ai)
#pragma unroll
                for (int m = 0; m < 4; ++m) { const int row = row0 + ai * HALF + m * 16; const float rs = rstd_of(ss[row]) * c2;
#pragma unroll
                    for (int bj = 0; bj < 2; ++bj)
#pragma unroll
                        for (int n = 0; n < 2; ++n) *(u32x2*)(QM + (size_t)row * 256 + bj * HALF + wc * 32 + n * 16 + fq * 4) = pk4(acc[ai][bj][m][n] * rs); }
        }
    }
};
struct EpiMemK {
    static constexpr bool PERM = false, AFTER_DRAIN = false;
    bf16_t* Kf; const float* ss;
    __device__ __forceinline__ void operator()(const f32x4 (&acc)[2][2][4][2], const Unit& u, int wr, int wc, int fr, int fq) const {
        const int row0 = u.pm * BM + wr * 64 + fr;
#pragma unroll
        for (int ai = 0; ai < 2; ++ai)
#pragma unroll
            for (int m = 0; m < 4; ++m) { const int row = row0 + ai * HALF + m * 16, b = row >> 8, key = row & 255; const float rs = rstd_of(ss[row]);
#pragma unroll
                for (int bj = 0; bj < 2; ++bj)
#pragma unroll
                    for (int n = 0; n < 2; ++n) { const int head = bj * 2 + (wc >> 1), ks = (wc & 1) * 2 + n;
                        bf16_t* p = Kf + (size_t)(b * 4 + head) * (256 * 64) + ((size_t)((key >> 5) * 4 + ks) * 64 + (fq >> 1) * 32 + (key & 31)) * 8 + (fq & 1) * 4;
                        *(u32x2*)p = pk4(acc[ai][bj][m][n] * rs); } }
    }
};
template <int LOGSEQ, int NH, int LOGD> struct EpiVt {
    static constexpr bool PERM = false, AFTER_DRAIN = false;
    bf16_t* Vf; const float* ss;
    __device__ __forceinline__ void operator()(const f32x4 (&acc)[2][2][4][2], const Unit& u, int wr, int wc, int fr, int fq) const {
        const int f0 = u.pm * BM + wr * 64 + fr, c0 = u.pn * BM + wc * 32 + fq * 4;
#pragma unroll
        for (int bj = 0; bj < 2; ++bj)
#pragma unroll
            for (int n = 0; n < 2; ++n) { const int c = c0 + bj * HALF + n * 16, b = c >> LOGSEQ, key = c & ((1 << LOGSEQ) - 1);
                const f32x4 s4 = *(const f32x4*)(ss + c); f32x4 rs; rs[0] = rstd_of(s4[0]); rs[1] = rstd_of(s4[1]); rs[2] = rstd_of(s4[2]); rs[3] = rstd_of(s4[3]);
#pragma unroll
                for (int ai = 0; ai < 2; ++ai)
#pragma unroll
                    for (int m = 0; m < 4; ++m) { const int f = f0 + ai * HALF + m * 16, head = f >> LOGD, d = f & ((1 << LOGD) - 1);
                        bf16_t* p = Vf + ((size_t)(b * NH + head) << (LOGSEQ + LOGD)) + ((size_t)(((key >> 5) * 2 + n) * (1 << (LOGD - 5)) + (d >> 5)) * 64 + (fq & 1) * 32 + (d & 31)) * 8 + (fq >> 1) * 4;
                        *(u32x2*)p = pk4(acc[ai][bj][m][n] * rs); } }
    }
};
template <bool FROM_F32, bool SCALE> struct EpiRes {
    static constexpr bool PERM = true, AFTER_DRAIN = false;
    const float* xin; bf16_t* x16; float* ssout; const float* ssin;
    __device__ __forceinline__ void operator()(const f32x4 (&acc)[2][2][4][2], const Unit& u, int wr, int wc, int fr, int fq) const {
        const int row0 = u.pm * BM + wr * 64 + fr, col0 = u.pn * BM + wc * 32 + fq * 8;
#pragma unroll
        for (int ai = 0; ai < 2; ++ai) {
            u32x4 w[4][2]; f32x4 xa[4][2][2]; float r2[4];
#pragma unroll
            for (int m = 0; m < 4; ++m) r2[m] = SCALE ? 1.0f / (ssin[row0 + ai * HALF + m * 16] * (1.0f / 1024.0f) + RMS_EPS) : 1.0f;
#pragma unroll
            for (int m = 0; m < 4; ++m)
#pragma unroll
                for (int bj = 0; bj < 2; ++bj) { const size_t off = (size_t)(row0 + ai * HALF + m * 16) * 1024 + col0 + bj * HALF;
                    if (FROM_F32) { xa[m][bj][0] = *(const f32x4*)(xin + off); xa[m][bj][1] = *(const f32x4*)(xin + off + 4); } else w[m][bj] = *(const u32x4*)(x16 + off); }
#pragma unroll
            for (int m = 0; m < 4; ++m) { const int row = row0 + ai * HALF + m * 16; float q = 0.f;
#pragma unroll
                for (int bj = 0; bj < 2; ++bj) { const size_t off = (size_t)row * 1024 + col0 + bj * HALF;
                    f32x4 x0, x1;
                    if (FROM_F32) { x0 = xa[m][bj][0]; x1 = xa[m][bj][1]; }
                    else { const u32x4 ww = w[m][bj];
                        x0[0] = __builtin_bit_cast(float, ww.x << 16); x0[1] = __builtin_bit_cast(float, ww.x & 0xffff0000u); x0[2] = __builtin_bit_cast(float, ww.y << 16); x0[3] = __builtin_bit_cast(float, ww.y & 0xffff0000u);
                        x1[0] = __builtin_bit_cast(float, ww.z << 16); x1[1] = __builtin_bit_cast(float, ww.z & 0xffff0000u); x1[2] = __builtin_bit_cast(float, ww.w << 16); x1[3] = __builtin_bit_cast(float, ww.w & 0xffff0000u); }
                    const f32x4 v0 = SCALE ? x0 + acc[ai][bj][m][0] * r2[m] : x0 + acc[ai][bj][m][0], v1 = SCALE ? x1 + acc[ai][bj][m][1] * r2[m] : x1 + acc[ai][bj][m][1];
                    u32x4 o; o.x = cvtpk(v0[0], v0[1]); o.y = cvtpk(v0[2], v0[3]); o.z = cvtpk(v1[0], v1[1]); o.w = cvtpk(v1[2], v1[3]);
                    *(u32x4*)(x16 + off) = o;
                    q += (v0[0] * v0[0] + v0[1] * v0[1]) + (v0[2] * v0[2] + v0[3] * v0[3]) + (v1[0] * v1[0] + v1[1] * v1[1]) + (v1[2] * v1[2] + v1[3] * v1[3]); }
                q += __shfl_xor(q, 16); q += __shfl_xor(q, 32);
                if (fq == 0) atomicAdd(ssout + row, q); }
        }
    }
};
struct EpiUp {
    static constexpr bool PERM = true, AFTER_DRAIN = false;
    bf16_t* H;
    __device__ __forceinline__ void operator()(const f32x4 (&acc)[2][2][4][2], const Unit& u, int wr, int wc, int fr, int fq) const {
        const int row0 = u.pm * BM + wr * 64 + fr, col0 = u.pn * BM + wc * 32 + fq * 8;
#pragma unroll
        for (int ai = 0; ai < 2; ++ai)
#pragma unroll
            for (int m = 0; m < 4; ++m) { const int row = row0 + ai * HALF + m * 16;
#pragma unroll
                for (int bj = 0; bj < 2; ++bj) { f32x4 v0 = acc[ai][bj][m][0], v1 = acc[ai][bj][m][1]; const f32x4 z = {0.f, 0.f, 0.f, 0.f};
                    v0 = __builtin_elementwise_max(v0, z); v1 = __builtin_elementwise_max(v1, z); v0 = v0 * v0; v1 = v1 * v1;
                    u32x4 o; o.x = cvtpk(v0[0], v0[1]); o.y = cvtpk(v0[2], v0[3]); o.z = cvtpk(v1[0], v1[1]); o.w = cvtpk(v1[2], v1[3]);
                    *(u32x4*)(H + (size_t)row * 4096 + col0 + bj * HALF) = o; } }
    }
};
template <class Epi, class Sched, bool ALIGN_EPI = false, bool SP2 = false>
__device__ __forceinline__ void gemm_phase(PG8_LAS unsigned char* lds, const Gemm g, const Sched& S, const Epi& E) {
    int tid_ = threadIdx.x; asm volatile("" : "+v"(tid_));
    const int tid = tid_, wid = __builtin_amdgcn_readfirstlane(tid >> 6), lane = tid & 63, wr = wid >> 2, wc = wid & 3, fr = lane & 15, fq = lane >> 4;
    const int K = g.K, nt = K / BK;
    unsigned voffA[2], voffB[2];
#pragma unroll
    for (int i = 0; i < 2; ++i) { int R, C; stage_rc(tid * 16 + i * 8192, R, C); const int Rb = Epi::PERM ? ((R & ~31) + perm32(R & 31)) : R;
        voffA[i] = (unsigned)(R * K + C) * 2u; voffB[i] = (unsigned)(Rb * K + C) * 2u; }
    const size_t kstep = (size_t)(BK * 2);
    const size_t hstep = (size_t)HALF * K * 2;
    const size_t tstep = 2 * hstep;
    const unsigned ldsw = (unsigned)wid * 1024u;
    const int aoff = lds_byte(wr * 64 + fr, fq * 8), boff = lds_byte(wc * 32 + fr, fq * 8);
#define PG8_SA(b, h) (((b) * 2 + (h)) * HTB)
#define PG8_SB(b, h) ((4 + (b) * 2 + (h)) * HTB)
#define PG8_STAGE(bufoff, gbase, voff) do { _Pragma("unroll") for (int _i = 0; _i < 2; ++_i) \
        __builtin_amdgcn_global_load_lds((const unsigned*)((const char*)(gbase) + (voff)[_i]), (PG8_LAS unsigned*)(lds + (bufoff) + ldsw + _i * 8192), 16, 0, 0); } while (0)
#define PG8_LDA(dst, b, h) do { _Pragma("unroll") for (int m = 0; m < 4; ++m) _Pragma("unroll") for (int k = 0; k < 2; ++k) dst[m][k] = *(const PG8_LAS bf16x8*)(lds + PG8_SA(b, h) + aoff + m * 2048 + k * 1024); } while (0)
#define PG8_LDB(dst, b, h) do { _Pragma("unroll") for (int n = 0; n < 2; ++n) _Pragma("unroll") for (int k = 0; k < 2; ++k) dst[n][k] = *(const PG8_LAS bf16x8*)(lds + PG8_SB(b, h) + boff + n * 2048 + k * 1024); } while (0)
#define PG8_MMA(ai, bj, At, Bt) do { __builtin_amdgcn_s_setprio(1); _Pragma("unroll") for (int m = 0; m < 4; ++m) _Pragma("unroll") for (int n = 0; n < 2; ++n) _Pragma("unroll") for (int k = 0; k < 2; ++k) \
        acc[ai][bj][m][n] = __builtin_amdgcn_mfma_f32_16x16x32_bf16(Bt[n][k], At[m][k], acc[ai][bj][m][n], 0, 0, 0); __builtin_amdgcn_s_setprio(0); } while (0)
#define PG8_WAIT_V(n) asm volatile("s_waitcnt vmcnt(" #n ")" ::: "memory")
#define PG8_WAIT_L(n) asm volatile("s_waitcnt lgkmcnt(" #n ")" ::: "memory")
#define PG8_BAR __builtin_amdgcn_s_barrier()
#define PG8_SCHED __builtin_amdgcn_sched_barrier(0)
    Unit cur, nxt; int ui = 0;
    if (!S.next(0, cur)) return;
    f32x4 acc[2][2][4][2];
#pragma unroll
    for (int a = 0; a < 2; ++a)
#pragma unroll
        for (int b = 0; b < 2; ++b)
#pragma unroll
            for (int m = 0; m < 4; ++m)
#pragma unroll
                for (int n = 0; n < 2; ++n) acc[a][b][m][n] = (f32x4){0.f, 0.f, 0.f, 0.f};
    bf16x8 At[4][2], B0[2][2], B1[2][2];
    const char* cA = (const char*)g.A + (size_t)cur.pm * tstep; const char* cB = (const char*)g.Bt + (size_t)cur.pn * tstep;
    S.a_ready(cur);
    if constexpr (SP2) {
        PG8_STAGE(PG8_SB(0, 0), cB, voffB); PG8_STAGE(PG8_SB(0, 1), cB + hstep, voffB); PG8_STAGE(PG8_SA(0, 0), cA, voffA); PG8_STAGE(PG8_SA(0, 1), cA + hstep, voffA);
        if (wr == 1) PG8_BAR;
        PG8_WAIT_V(2); PG8_BAR;
        PG8_STAGE(PG8_SB(1, 0), cB + kstep, voffB); PG8_STAGE(PG8_SA(1, 0), cA + kstep, voffA); PG8_STAGE(PG8_SB(1, 1), cB + hstep + kstep, voffB);
        PG8_WAIT_V(6); PG8_BAR;
    } else {
        PG8_STAGE(PG8_SB(0, 0), cB, voffB); PG8_STAGE(PG8_SA(0, 0), cA, voffA); PG8_STAGE(PG8_SB(0, 1), cB + hstep, voffB); PG8_STAGE(PG8_SA(0, 1), cA + hstep, voffA);
        if (wr == 1) PG8_BAR;
        PG8_WAIT_V(4); PG8_BAR;
        PG8_STAGE(PG8_SB(1, 0), cB + kstep, voffB); PG8_STAGE(PG8_SA(1, 0), cA + kstep, voffA); PG8_STAGE(PG8_SB(1, 1), cB + hstep + kstep, voffB);
        PG8_WAIT_V(6); PG8_BAR;
    }
    for (;;) {
        const bool has_next = S.next(ui + 1, nxt);
        const char* nA = has_next ? (const char*)g.A + (size_t)nxt.pm * tstep : cA; const char* nB = has_next ? (const char*)g.Bt + (size_t)nxt.pn * tstep : cB;
        for (int t = 0; t < nt; t += 2) {
            const bool last = (t == nt - 2);
            const char* a1 = cA + (size_t)(t + 1) * kstep;
            const char* a2 = last ? nA : cA + (size_t)(t + 2) * kstep; const char* b2 = last ? nB : cB + (size_t)(t + 2) * kstep;
            const char* a3 = a2 + kstep; const char* b3 = b2 + kstep;
            if (last && has_next) S.a_ready(nxt);
            if constexpr (SP2) {
            PG8_LDB(B0, 0, 0); PG8_LDB(B1, 0, 1); PG8_SCHED; PG8_LDA(At, 0, 0); PG8_STAGE(PG8_SA(1, 1), a1 + hstep, voffA);
            PG8_WAIT_V(8); PG8_WAIT_L(0); PG8_BAR; PG8_MMA(0, 0, At, B0); PG8_MMA(0, 1, At, B1); PG8_BAR; PG8_SCHED;
            PG8_LDA(At, 0, 1); PG8_STAGE(PG8_SB(0, 0), b2, voffB); PG8_STAGE(PG8_SB(0, 1), b2 + hstep, voffB); PG8_STAGE(PG8_SA(0, 0), a2, voffA);
            PG8_WAIT_V(8); PG8_WAIT_L(0); PG8_BAR; PG8_MMA(1, 0, At, B0); PG8_MMA(1, 1, At, B1); PG8_BAR; PG8_SCHED;
            PG8_LDB(B0, 1, 0); PG8_LDB(B1, 1, 1); PG8_SCHED; PG8_LDA(At, 1, 0); PG8_STAGE(PG8_SA(0, 1), a2 + hstep, voffA);
            PG8_WAIT_V(8); PG8_WAIT_L(0); PG8_BAR; PG8_MMA(0, 0, At, B0); PG8_MMA(0, 1, At, B1); PG8_BAR; PG8_SCHED;
            PG8_LDA(At, 1, 1); PG8_STAGE(PG8_SB(1, 0), b3, voffB); PG8_STAGE(PG8_SB(1, 1), b3 + hstep, voffB); PG8_STAGE(PG8_SA(1, 0), a3, voffA);
            PG8_WAIT_V(8); PG8_WAIT_L(0); PG8_BAR; PG8_MMA(1, 0, At, B0); PG8_MMA(1, 1, At, B1); PG8_BAR; PG8_SCHED;
            } else {
            PG8_LDB(B0, 0, 0); PG8_SCHED; PG8_LDA(At, 0, 0); PG8_STAGE(PG8_SA(1, 1), a1 + hstep, voffA);
            PG8_WAIT_L(8); PG8_BAR; PG8_WAIT_L(0); PG8_MMA(0, 0, At, B0); PG8_BAR; PG8_SCHED;
            PG8_LDB(B1, 0, 1); PG8_STAGE(PG8_SB(0, 0), b2, voffB);
            PG8_BAR; PG8_WAIT_L(0); PG8_MMA(0, 1, At, B1); PG8_BAR;
            PG8_LDA(At, 0, 1); PG8_STAGE(PG8_SA(0, 0), a2, voffA);
            PG8_BAR; PG8_WAIT_L(0); PG8_MMA(1, 0, At, B0); PG8_BAR; PG8_SCHED;
            PG8_STAGE(PG8_SB(0, 1), b2 + hstep, voffB);
            PG8_WAIT_V(6); PG8_BAR; PG8_MMA(1, 1, At, B1); PG8_BAR;
            PG8_LDB(B0, 1, 0); PG8_SCHED; PG8_LDA(At, 1, 0); PG8_STAGE(PG8_SA(0, 1), a2 + hstep, voffA);
            PG8_WAIT_L(8); PG8_BAR; PG8_WAIT_L(0); PG8_MMA(0, 0, At, B0); PG8_BAR; PG8_SCHED;
            PG8_LDB(B1, 1, 1); PG8_STAGE(PG8_SB(1, 0), b3, voffB);
            PG8_BAR; PG8_WAIT_L(0); PG8_MMA(0, 1, At, B1); PG8_BAR;
            PG8_LDA(At, 1, 1); PG8_STAGE(PG8_SA(1, 0), a3, voffA);
            PG8_BAR; PG8_WAIT_L(0); PG8_MMA(1, 0, At, B0); PG8_BAR; PG8_SCHED;
            PG8_STAGE(PG8_SB(1, 1), b3 + hstep, voffB);
            PG8_WAIT_V(6); PG8_BAR; PG8_MMA(1, 1, At, B1); PG8_BAR;
            }
        }
        if constexpr (ALIGN_EPI) { if (wr == 0) PG8_BAR; }
        if constexpr (!Epi::AFTER_DRAIN) { E(acc, cur, wr, wc, fr, fq); S.done(cur); }
        if (!has_next) break;
#pragma unroll
        for (int a = 0; a < 2; ++a)
#pragma unroll
            for (int b = 0; b < 2; ++b)
#pragma unroll
                for (int m = 0; m < 4; ++m)
#pragma unroll
                    for (int n = 0; n < 2; ++n) acc[a][b][m][n] = (f32x4){0.f, 0.f, 0.f, 0.f};
        cur = nxt; cA = nA; cB = nB; ++ui;
        if constexpr (ALIGN_EPI) { if (wr == 1) PG8_BAR; }
    }
    PG8_WAIT_V(0);
    if constexpr (!ALIGN_EPI) { if (wr == 0) PG8_BAR; }
    PG8_BAR;
    if constexpr (Epi::AFTER_DRAIN) { E.fused(acc, cur, wr, wc, fr, fq, lds, wid, lane); S.done(cur); }
#undef PG8_SA
#undef PG8_SB
#undef PG8_STAGE
#undef PG8_LDA
#undef PG8_LDB
#undef PG8_MMA
#undef PG8_WAIT_V
#undef PG8_WAIT_L
#undef PG8_BAR
#undef PG8_SCHED
}
}

#define LAS __attribute__((address_space(3)))
#define GAS __attribute__((address_space(1)))
typedef unsigned short bf16_t;
typedef short bf16x8 __attribute__((ext_vector_type(8)));
typedef float f32x4 __attribute__((ext_vector_type(4)));
typedef float f32x16 __attribute__((ext_vector_type(16)));
typedef unsigned u32x4 __attribute__((ext_vector_type(4)));
typedef unsigned u32x2 __attribute__((ext_vector_type(2)));
typedef int i32x4 __attribute__((ext_vector_type(4)));
using pg8::cvtpk; using pg8::pk4; using pg8::rstd_of;

constexpr int NWAVES = 8, NTHREADS = 512;
constexpr int BATCH = 4, SEQ = 8192, DM = 1024, MTOK = BATCH * SEQ, FF = 4096, MEMLEN = 256, MEMROWS = BATCH * MEMLEN;
constexpr float C2 = 0.125f * 1.4426950408889634f;
constexpr size_t MiB = 1u << 20;
constexpr size_t WS_SS = 0;
constexpr size_t WS_KMS = 512 * 1024;
constexpr size_t WS_SS0 = 1 * MiB, WS_SSM = WS_SS0 + 128 * 1024;
constexpr size_t WS_COS = 2 * MiB, WS_SIN = 3 * MiB;
constexpr size_t WS_BAR = 1 * MiB + 512 * 1024;
constexpr size_t WS_WA_IN = 4 * MiB, WS_WA_V = 8 * MiB, WS_WA_OUT = 10 * MiB, WS_WA_UP = 12 * MiB, WS_WA_DOWN = 20 * MiB, WS_WB_IN = 28 * MiB, WS_WB_V = 32 * MiB, WS_WB_OUT = 34 * MiB,
                 WS_WB_UP = 36 * MiB, WS_WB_DOWN = 44 * MiB, WS_WA_MEM = 52 * MiB, WS_WB_MEM = 53 * MiB, WS_MEM16 = 54 * MiB,
                 WS_MKA = 56 * MiB, WS_MVA = 56 * MiB + 512 * 1024, WS_MKB = 57 * MiB, WS_MVB = 57 * MiB + 512 * 1024;
constexpr size_t WS_X16 = 64 * MiB, WS_ATT = 128 * MiB, WS_BIG = 192 * MiB, WS_END = 490 * MiB;
constexpr size_t BG_QA = 0, BG_KA = 48 * MiB, BG_VA = 96 * MiB, BG_OA = 144 * MiB, BG_QMA = 240 * MiB;
constexpr size_t BG_QB = 0, BG_KB = 48 * MiB, BG_VB = 96 * MiB, BG_QMB = 144 * MiB, BG_PART = 160 * MiB;
constexpr int PSTR = 68;
constexpr size_t PART_BYTES = (size_t)256 * 4 * PSTR * 4;
static_assert(BG_PART + 256 * PART_BYTES <= 256 * MiB, "partials fit");
constexpr int LDS_BYTES = 147456;

struct WDesc { const float* src; const float* gain; bf16_t* dst; int K, N, col0, ncols, rowoff, perm, start, pad; };
constexpr int NWD = 16;
struct Params {
    const float *x, *mem, *a_lambda, *a_subln, *final_norm;
    float* out; unsigned char* ws;
    WDesc wd[NWD]; int nitems; int nearly;
    float inv[32];
};

__device__ __forceinline__ unsigned f2bf(float f) { unsigned u = __builtin_bit_cast(unsigned, f); return (u + 0x7fffu + ((u >> 16) & 1u)) >> 16; }
__device__ __forceinline__ float bf2f(unsigned h) { return __builtin_bit_cast(float, h << 16); }
__device__ __forceinline__ float wave_sum(float v) {
#pragma unroll
    for (int o = 1; o < 64; o <<= 1) v += __shfl_xor(v, o);
    return v;
}
__device__ __forceinline__ int crow(int r, int hi) { return (r & 3) + 8 * (r >> 2) + 4 * hi; }
#define MFMA32(a, b, c) __builtin_amdgcn_mfma_f32_32x32x16_bf16((a), (b), (c), 0, 0, 0)

__device__ __forceinline__ unsigned long long rfl64(unsigned long long v) { const unsigned lo = __builtin_amdgcn_readfirstlane((unsigned)v), hi = __builtin_amdgcn_readfirstlane((unsigned)(v >> 32)); return ((unsigned long long)hi << 32) | lo; }
__device__ __forceinline__ void p0_transpose_item(const WDesc& w, LAS float* scr, int item, int lane) {
    const int nblk = w.ncols / 32, kb = item / nblk, nb = item % nblk, k0 = 64 * kb, n0 = 32 * nb;
    f32x4 tv[8];
#pragma unroll
    for (int i = 0; i < 8; ++i) tv[i] = __builtin_nontemporal_load((const f32x4*)(w.src + (size_t)(k0 + (lane >> 3) + 8 * i) * w.N + w.col0 + n0 + 4 * (lane & 7)));
    const float g0 = w.gain ? w.gain[k0 + lane] : 1.f;
#pragma unroll
    for (int i = 0; i < 8; ++i) { const int kk = (lane >> 3) + 8 * i; const float g = __shfl(g0, kk); LAS float* d = scr + kk * 33 + 4 * (lane & 7);
        d[0] = tv[i][0] * g; d[1] = tv[i][1] * g; d[2] = tv[i][2] * g; d[3] = tv[i][3] * g; }
    asm volatile("s_waitcnt lgkmcnt(0)" ::: "memory");
    const int c = lane & 7;
#pragma unroll
    for (int j = 0; j < 4; ++j) { const int n = (lane >> 3) + 8 * j; const LAS float* s = scr + (8 * c) * 33 + n;
        u32x4 o; o.x = cvtpk(s[0 * 33], s[1 * 33]); o.y = cvtpk(s[2 * 33], s[3 * 33]); o.z = cvtpk(s[4 * 33], s[5 * 33]); o.w = cvtpk(s[6 * 33], s[7 * 33]);
        int nn = n0 + n; if (w.perm) nn = (nn & ~0x30) | ((nn & 0x10) << 1) | ((nn & 0x20) >> 1);
        *(u32x4*)(w.dst + (size_t)(w.rowoff + nn) * w.K + k0 + 8 * c) = o; }
    asm volatile("s_waitcnt lgkmcnt(0)" ::: "memory");
}
template <int NR> __device__ __forceinline__ void rows_to_bf16(const float* x0, bf16_t* o0, float* ssp, size_t rstride, int lane) {
    f32x4 v[NR][4];
#pragma unroll
    for (int q = 0; q < NR; ++q) { const f32x4* xr = (const f32x4*)(x0 + q * rstride * 1024) + 2 * lane;
#pragma unroll
        for (int j = 0; j < 2; ++j) { v[q][2 * j] = __builtin_nontemporal_load(xr + 128 * j); v[q][2 * j + 1] = __builtin_nontemporal_load(xr + 128 * j + 1); } }
#pragma unroll
    for (int q = 0; q < NR; ++q) { float s = 0.f;
#pragma unroll
        for (int j = 0; j < 4; ++j) s += (v[q][j][0] * v[q][j][0] + v[q][j][1] * v[q][j][1]) + (v[q][j][2] * v[q][j][2] + v[q][j][3] * v[q][j][3]);
        s = wave_sum(s);
        u32x4* o16 = (u32x4*)(o0 + q * rstride * 1024) + lane;
#pragma unroll
        for (int j = 0; j < 2; ++j) { u32x4 o; o.x = cvtpk(v[q][2 * j][0], v[q][2 * j][1]); o.y = cvtpk(v[q][2 * j][2], v[q][2 * j][3]); o.z = cvtpk(v[q][2 * j + 1][0], v[q][2 * j + 1][1]); o.w = cvtpk(v[q][2 * j + 1][2], v[q][2 * j + 1][3]); o16[64 * j] = o; }
        if (lane == 0) ssp[q * rstride] = s; }
}
__device__ __forceinline__ void sincos_acc(float a, float& s, float& c) {
    const double x = (double)a, k = __builtin_rint(x * 0.63661977236758134308);
    double r = x - k * 1.57079632679489661923; r -= k * 6.123233995736766e-17;
    const int q = (int)k & 3; const double r2 = r * r;
    const double sp = r * (1.0 + r2 * (-1.0 / 6 + r2 * (1.0 / 120 + r2 * (-1.0 / 5040 + r2 * (1.0 / 362880 + r2 * (-1.0 / 39916800 + r2 * (1.0 / 6227020800.0)))))));
    const double cp = 1.0 + r2 * (-0.5 + r2 * (1.0 / 24 + r2 * (-1.0 / 720 + r2 * (1.0 / 40320 + r2 * (-1.0 / 3628800 + r2 * (1.0 / 479001600 + r2 * (-1.0 / 87178291200.0)))))));
    const double ss = (q == 0) ? sp : (q == 1) ? cp : (q == 2) ? -sp : -cp, cc = (q == 0) ? cp : (q == 1) ? -sp : (q == 2) ? -cp : sp;
    s = (float)ss; c = (float)cc;
}

__device__ __forceinline__ void flash_wave(const bf16x8 (&qf)[4], const bf16_t* Kf, const bf16_t* Vf, int nchunk, int qlim, bool masked, LAS float* sc, int lane,
                                           float& m, float& l, f32x16& o0, f32x16& o1) {
    const int hh = lane >> 5;
    bf16x8 ka[8], vb[8];
#pragma unroll
    for (int f = 0; f < 8; ++f) { ka[f] = *(const bf16x8*)(Kf + lane * 8 + f * 512); vb[f] = *(const bf16x8*)(Vf + lane * 8 + f * 512); }
#pragma unroll 1
    for (int c = 0; c < nchunk; ++c) {
        const size_t nx = (size_t)(c + 1 < nchunk ? c + 1 : c) * 4096 + lane * 8;
        bf16x8 kn[8], vn[8];
#pragma unroll
        for (int f = 0; f < 8; ++f) { kn[f] = *(const bf16x8*)(Kf + nx + f * 512); vn[f] = *(const bf16x8*)(Vf + nx + f * 512); }
        f32x16 p0 = {}, p1 = {};
#pragma unroll
        for (int ks = 0; ks < 4; ++ks) { p0 = MFMA32(ka[ks], qf[ks], p0); p1 = MFMA32(ka[4 + ks], qf[ks], p1); }
        if (masked) {
#pragma unroll
            for (int i = 0; i < 16; ++i) { const int kc = (i & 3) + 8 * (i >> 2), t0 = qlim - c * 64 - 4 * hh; if (kc > t0) p0[i] = -INFINITY; if (kc + 32 > t0) p1[i] = -INFINITY; }
        }
        float rm = fmaxf(p0[0], p1[0]);
#pragma unroll
        for (int i = 1; i < 16; ++i) rm = fmaxf(rm, fmaxf(p0[i], p1[i]));
        rm = fmaxf(rm, __shfl_xor(rm, 32));
        const float mn = fmaxf(m, rm), alpha = __builtin_amdgcn_exp2f(m - mn);
        float sum = 0.f;
#pragma unroll
        for (int i = 0; i < 16; ++i) { p0[i] = __builtin_amdgcn_exp2f(p0[i] - mn); p1[i] = __builtin_amdgcn_exp2f(p1[i] - mn); sum += p0[i] + p1[i]; }
        l = l * alpha + sum; m = mn;
        if (__any(alpha != 1.0f)) {
            sc[lane & 31] = alpha;
#pragma unroll
            for (int g = 0; g < 4; ++g) { const f32x4 a = *(const LAS f32x4*)(sc + 8 * g + 4 * hh);
#pragma unroll
                for (int e = 0; e < 4; ++e) { o0[4 * g + e] *= a[e]; o1[4 * g + e] *= a[e]; } }
        }
#pragma unroll
        for (int s = 0; s < 2; ++s) {
            u32x4 w0, w1;
#pragma unroll
            for (int e = 0; e < 4; ++e) { w0[e] = cvtpk(p0[8 * s + 2 * e], p0[8 * s + 2 * e + 1]); w1[e] = cvtpk(p1[8 * s + 2 * e], p1[8 * s + 2 * e + 1]); }
            const bf16x8 a0 = __builtin_bit_cast(bf16x8, w0), a1 = __builtin_bit_cast(bf16x8, w1);
            o0 = MFMA32(a0, vb[s * 2 + 0], o0); o1 = MFMA32(a0, vb[s * 2 + 1], o1);
            o0 = MFMA32(a1, vb[4 + s * 2 + 0], o0); o1 = MFMA32(a1, vb[4 + s * 2 + 1], o1);
        }
#pragma unroll
        for (int f = 0; f < 8; ++f) { ka[f] = kn[f]; vb[f] = vn[f]; }
    }
}
__device__ __forceinline__ void mem_attn_phase(const bf16_t* QM, const bf16_t* MK, const bf16_t* MV, bf16_t* att, LAS float* sc, int gw, int ngw, int lane) {
    const int r = lane & 31, hh = lane >> 5;
    for (int it = gw; it < (MTOK / 32) * 4; it += ngw) {
        asm volatile("" : "+s"(QM), "+s"(MK), "+s"(MV), "+s"(att));
        const int head = it & 3, row0 = (it >> 2) * 32, b = row0 >> 13;
        bf16x8 qf[4];
#pragma unroll
        for (int ks = 0; ks < 4; ++ks) qf[ks] = *(const bf16x8*)(QM + (size_t)(row0 + r) * 256 + head * 64 + ks * 16 + hh * 8);
        float m = -INFINITY, l = 0.f; f32x16 o0 = {}, o1 = {};
        flash_wave(qf, MK + (size_t)(b * 4 + head) * (256 * 64), MV + (size_t)(b * 4 + head) * (256 * 64), 4, 1 << 30, false, sc, lane, m, l, o0, o1);
        l += __shfl_xor(l, 32);
        sc[r] = 1.0f / l;
#pragma unroll
        for (int g = 0; g < 4; ++g) { const f32x4 a = *(const LAS f32x4*)(sc + 8 * g + 4 * hh);
#pragma unroll
            for (int e = 0; e < 4; ++e) { const int i = 4 * g + e; bf16_t* p = att + (size_t)(row0 + crow(i, hh)) * 1024 + 768 + head * 64 + r;
                p[0] = (bf16_t)f2bf(o0[i] * a[e]); p[32] = (bf16_t)f2bf(o1[i] * a[e]); } }
    }
}
constexpr int ML_CNT = 0, ML_IST = 256, ML_LIST = 512, ML_SCR = 512 + 32 * 256 * 2, ML_SCR_STRIDE = 512;
#define TOP3_INSERT(g_, j_) do { const float gg_ = (g_); const int jj_ = (j_); const bool c0_ = gg_ > v0, c1_ = gg_ > v1, c2_ = gg_ > v2; \
    v2 = c1_ ? v1 : (c2_ ? gg_ : v2); i2 = c1_ ? i1 : (c2_ ? jj_ : i2); v1 = c0_ ? v0 : (c1_ ? gg_ : v1); i1 = c0_ ? i0 : (c1_ ? jj_ : i1); v0 = c0_ ? gg_ : v0; i0 = c0_ ? jj_ : i0; } while (0)
__device__ __forceinline__ void moba_phase(const bf16_t* Q, const bf16_t* Kf, const bf16_t* Vf, const float* kms, float* part, bf16_t* att, LAS unsigned char* lds, int tid) {
    const int lane = tid & 63, wave = __builtin_amdgcn_readfirstlane(tid >> 6), r = lane & 31, hh = lane >> 5;
    LAS int* cnt = (LAS int*)(lds + ML_CNT); LAS int* ist = (LAS int*)(lds + ML_IST); LAS unsigned short* list = (LAS unsigned short*)(lds + ML_LIST);
    LAS float* sc = (LAS float*)(lds + ML_SCR + wave * ML_SCR_STRIDE); LAS int* sci = (LAS int*)(sc + 32);
    const int nu = 48 * 32, G_ = gridDim.x;
    for (int u0 = blockIdx.x; u0 < nu; u0 += G_) {
        int cur, bh;
        if (G_ == 256) { const int x = u0 & 7, ci = (u0 >> 3) & 31, rho = u0 >> 8; bh = 6 * x + rho; cur = (rho & 1) ? ci : 31 - ci; }
        else { cur = 31 - u0 / 48; bh = u0 % 48; }
        const int b = bh / 12, h = bh % 12;
        const size_t tok0 = (size_t)b * SEQ + cur * 256;
        const bf16_t* Kbh = Kf + (size_t)bh * (SEQ * 64); const bf16_t* Vbh = Vf + (size_t)bh * (SEQ * 64);
        if (tid < 32) cnt[tid] = 0;
        __syncthreads();
        if (cur > 0) {
            bf16x8 qf[4];
#pragma unroll
            for (int ks = 0; ks < 4; ++ks) qf[ks] = *(const bf16x8*)(Q + (tok0 + wave * 32 + r) * 768 + h * 64 + ks * 16 + hh * 8);
            f32x16 ga = {};
            const float* kr = kms + ((size_t)(bh * 32 + r)) * 64 + hh * 8;
#pragma unroll
            for (int ks = 0; ks < 4; ++ks) { const f32x4 x0 = *(const f32x4*)(kr + ks * 16), x1 = *(const f32x4*)(kr + ks * 16 + 4);
                u32x4 hi, lo;
#pragma unroll
                for (int e = 0; e < 2; ++e) { const float a0 = x0[2 * e], a1 = x0[2 * e + 1], b0 = x1[2 * e], b1 = x1[2 * e + 1];
                    hi[e] = cvtpk(a0, a1); hi[2 + e] = cvtpk(b0, b1);
                    lo[e] = cvtpk(a0 - bf2f(hi[e] & 0xffffu), a1 - bf2f(hi[e] >> 16)); lo[2 + e] = cvtpk(b0 - bf2f(hi[2 + e] & 0xffffu), b1 - bf2f(hi[2 + e] >> 16)); }
                ga = MFMA32(__builtin_bit_cast(bf16x8, hi), qf[ks], ga); ga = MFMA32(__builtin_bit_cast(bf16x8, lo), qf[ks], ga); }
            float v0 = -INFINITY, v1 = -INFINITY, v2 = -INFINITY; int i0 = -1, i1 = -1, i2 = -1;
#pragma unroll
            for (int i = 0; i < 16; ++i) { const int j = crow(i, hh); const float g = (j < cur) ? ga[i] : -INFINITY; TOP3_INSERT(g, j); }
            const float p0 = __shfl_xor(v0, 32), p1 = __shfl_xor(v1, 32), p2 = __shfl_xor(v2, 32); const int q0 = __shfl_xor(i0, 32), q1 = __shfl_xor(i1, 32), q2 = __shfl_xor(i2, 32);
            TOP3_INSERT(p0, q0); TOP3_INSERT(p1, q1); TOP3_INSERT(p2, q2);
            if (hh == 0) { const int qi = wave * 32 + r;
                if (i0 >= 0) { const int p = atomicAdd((int*)&cnt[i0], 1); list[i0 * 256 + p] = (unsigned short)(qi | (0 << 8)); }
                if (i1 >= 0) { const int p = atomicAdd((int*)&cnt[i1], 1); list[i1 * 256 + p] = (unsigned short)(qi | (1 << 8)); }
                if (i2 >= 0) { const int p = atomicAdd((int*)&cnt[i2], 1); list[i2 * 256 + p] = (unsigned short)(qi | (2 << 8)); } }
        }
        __syncthreads();
        if (tid == 0) { int a = 0; for (int j = 0; j < 32; ++j) { ist[j] = a; a += (j < cur) ? ((cnt[j] + 31) >> 5) : 0; } ist[32] = a; }
        __syncthreads();
        const int nsel = ist[32];
        for (int x = wave; x < nsel + 8; x += NWAVES) {
            int j, qi, slot, nchunk, qlim; bool valid, masked;
            if (x < nsel) { j = 0; while (ist[j + 1] <= x) ++j; const int g = x - ist[j], n = cnt[j], p = g * 32 + r; valid = p < n;
                const int e = list[j * 256 + (valid ? p : n - 1)]; qi = e & 255; slot = e >> 8; nchunk = 4; qlim = 1 << 30; masked = false; }
            else { const int g = x - nsel; j = cur; qi = g * 32 + r; slot = 3; valid = true; nchunk = (g >> 1) + 1; qlim = qi; masked = true; }
            bf16x8 qf[4];
#pragma unroll
            for (int ks = 0; ks < 4; ++ks) qf[ks] = *(const bf16x8*)(Q + (tok0 + qi) * 768 + h * 64 + ks * 16 + hh * 8);
            float m = -INFINITY, l = 0.f; f32x16 o0 = {}, o1 = {};
            flash_wave(qf, Kbh + (size_t)j * (256 * 64), Vbh + (size_t)j * (256 * 64), nchunk, qlim, masked, sc, lane, m, l, o0, o1);
            l += __shfl_xor(l, 32);
            sci[r] = valid ? (qi * 4 + slot) : -1;
#pragma unroll
            for (int g = 0; g < 4; ++g) { const i32x4 rid = *(const LAS i32x4*)(sci + 8 * g + 4 * hh);
#pragma unroll
                for (int e = 0; e < 4; ++e) if (rid[e] >= 0) { float* p = part + (size_t)rid[e] * PSTR + r; p[0] = o0[4 * g + e]; p[32] = o1[4 * g + e]; } }
            if (valid && hh == 0) { float* p = part + (size_t)(qi * 4 + slot) * PSTR + 64; p[0] = m; p[1] = l; }
        }
        __syncthreads();
        { const int qi = tid >> 1, dh = tid & 1, nv = cur < 3 ? cur : 3;
            const float* pq = part + (size_t)(qi * 4) * PSTR;
            float mk[4], lk[4]; float M = pq[3 * PSTR + 64]; mk[3] = M; lk[3] = pq[3 * PSTR + 65];
#pragma unroll
            for (int k = 0; k < 3; ++k) { if (k < nv) { mk[k] = pq[k * PSTR + 64]; lk[k] = pq[k * PSTR + 65]; M = fmaxf(M, mk[k]); } else { mk[k] = -INFINITY; lk[k] = 0.f; } }
            float wk[4], L = 0.f;
#pragma unroll
            for (int k = 0; k < 4; ++k) { wk[k] = (k == 3 || k < nv) ? __builtin_amdgcn_exp2f(mk[k] - M) : 0.f; L += wk[k] * lk[k]; }
            const float invL = 1.0f / L;
            bf16_t* op = att + (tok0 + qi) * 1024 + h * 64 + dh * 32;
#pragma unroll
            for (int c = 0; c < 4; ++c) { f32x4 a0 = {0.f, 0.f, 0.f, 0.f}, a1 = {0.f, 0.f, 0.f, 0.f};
#pragma unroll
                for (int k = 0; k < 4; ++k) if (k == 3 || k < nv) { const f32x4* s = (const f32x4*)(pq + k * PSTR + dh * 32 + c * 8); a0 += s[0] * wk[k]; a1 += s[1] * wk[k]; }
                a0 = a0 * invL; a1 = a1 * invL;
                u32x4 o; o.x = cvtpk(a0[0], a0[1]); o.y = cvtpk(a0[2], a0[3]); o.z = cvtpk(a1[0], a1[1]); o.w = cvtpk(a1[2], a1[3]);
                *(u32x4*)(op + c * 8) = o; }
        }
        __syncthreads();
    }
}
__device__ __forceinline__ void diff_combine_phase(const bf16_t* O, const float* lamp, const float* subln, bf16_t* att, int gw, int ngw, int lane) {
    const float s01 = wave_sum(lamp[lane] * lamp[64 + lane]), s23 = wave_sum(lamp[128 + lane] * lamp[192 + lane]);
    const float lam_init = 0.2f, lam = expf(s01) - expf(s23) + lam_init;
    const int sub = lane >> 4, e16 = lane & 15;
    const f32x4 g0 = *(const f32x4*)(subln + e16 * 8), g1 = *(const f32x4*)(subln + e16 * 8 + 4);
    for (int it0 = gw; it0 + 3 * ngw < MTOK * 6 / 4; it0 += 4 * ngw) {
        u32x4 av[4], cv[4];
#pragma unroll
        for (int q = 0; q < 4; ++q) { const int pr = (it0 + q * ngw) * 4 + sub, row = pr / 6, hd = pr % 6; const bf16_t* p1 = O + (size_t)row * 1536 + hd * 256 + e16 * 8; av[q] = *(const u32x4*)p1; cv[q] = *(const u32x4*)(p1 + 128); }
#pragma unroll
        for (int q = 0; q < 4; ++q) { const int pr = (it0 + q * ngw) * 4 + sub, row = pr / 6, hd = pr % 6; const u32x4 a = av[q], c = cv[q];
        float o[8]; float qq = 0.f;
#pragma unroll
        for (int e = 0; e < 4; ++e) { o[2 * e] = bf2f(a[e] & 0xffffu) - lam * bf2f(c[e] & 0xffffu); o[2 * e + 1] = bf2f(a[e] >> 16) - lam * bf2f(c[e] >> 16); qq += o[2 * e] * o[2 * e] + o[2 * e + 1] * o[2 * e + 1]; }
#pragma unroll
        for (int s = 1; s < 16; s <<= 1) qq += __shfl_xor(qq, s);
        const float rs = (1.0f / sqrtf(qq * (1.0f / 128.0f) + 1e-6f)) * (1.0f - lam_init);
        u32x4 w; w.x = cvtpk(o[0] * rs * g0[0], o[1] * rs * g0[1]); w.y = cvtpk(o[2] * rs * g0[2], o[3] * rs * g0[3]); w.z = cvtpk(o[4] * rs * g1[0], o[5] * rs * g1[1]); w.w = cvtpk(o[6] * rs * g1[2], o[7] * rs * g1[3]);
        *(u32x4*)(att + (size_t)row * 1024 + hd * 128 + e16 * 8) = w; }
    }
}
constexpr int DA_KS = 8192, DA_VS = 16384, DA_KOFF = 0, DA_VOFF = 3 * DA_KS, DA_SCR = DA_VOFF + 2 * DA_VS;
constexpr float DA_THR = 8.0f;
__device__ __forceinline__ void diff_attn_phase(const bf16_t* Q, const bf16_t* Kf, const bf16_t* Vf, bf16_t* O, LAS unsigned char* lds, int tid) {
    const int lane = tid & 63, wave = __builtin_amdgcn_readfirstlane(tid >> 6), r = lane & 31, hh = lane >> 5;
    LAS float* sc = (LAS float*)(lds + DA_SCR + wave * 512);
    if (wave >= 4) __builtin_amdgcn_s_setprio(1);
    const int G = gridDim.x, bx = blockIdx.x, vcu = (G % 8 == 0) ? (bx % 8) * (G / 8) + bx / 8 : bx;
#pragma unroll 1
    for (int pi = vcu; pi < 768; pi += G) {
        asm volatile("" : "+s"(Q), "+s"(Kf), "+s"(Vf), "+s"(O));
        const int bvh = pi >> 4, s16 = pi & 15, b = bvh / 12, vh = bvh % 12;
        const bf16_t* Kseq = Kf + (size_t)(b * 12 + vh) * (SEQ * 64); const bf16_t* Vseq = Vf + (size_t)(b * 6 + (vh >> 1)) * (SEQ * 128);
#pragma unroll 1
        for (int half = 0; half < 2; ++half) {
            asm volatile("" : "+s"(Q), "+s"(O));
            const int qb = half ? 31 - s16 : s16, nc = 4 * (qb + 1);
            const int nact = nc - 4 + ((wave * 32 + 31) >> 6) + 1;
            const size_t tok0 = (size_t)b * SEQ + qb * 256 + wave * 32;
            bf16x8 qf[4];
#pragma unroll
            for (int ks = 0; ks < 4; ++ks) qf[ks] = *(const bf16x8*)(Q + (tok0 + r) * 768 + vh * 64 + ks * 16 + hh * 8);
            const bf16_t* srck = Kseq + tid * 8;
            const bf16_t* srcv = Vseq + tid * 8;
#define DA_DMA_K(cc, slot) __builtin_amdgcn_global_load_lds((const GAS unsigned*)(srck + (size_t)(cc) * 4096), (LAS unsigned*)(lds + DA_KOFF + (slot) * DA_KS + wave * 1024), 16, 0, 0)
#define DA_DMA_V(cc, slot) do { __builtin_amdgcn_global_load_lds((const GAS unsigned*)(srcv + (size_t)(cc) * 8192), (LAS unsigned*)(lds + DA_VOFF + (slot) * DA_VS + wave * 1024), 16, 0, 0); \
                                __builtin_amdgcn_global_load_lds((const GAS unsigned*)(srcv + (size_t)(cc) * 8192 + 4096), (LAS unsigned*)(lds + DA_VOFF + (slot) * DA_VS + 8192 + wave * 1024), 16, 0, 0); } while (0)
            DA_DMA_K(0, 0); DA_DMA_K(1, 1); DA_DMA_V(0, 0);
            asm volatile("s_waitcnt vmcnt(0)" ::: "memory");
            __syncthreads();
            float m = 0.f, l = 0.f; f32x16 o0 = {}, o1 = {}, o2 = {}, o3 = {}; const f32x16 zero16 = {};
            const int qlim = wave * 32 + r;
            f32x16 sa0 = {}, sa1 = {}, sb0, sb1;
            {
                const LAS unsigned char* kb = lds + DA_KOFF + lane * 16;
#pragma unroll
                for (int ks = 0; ks < 4; ++ks) { sa0 = MFMA32(*(const LAS bf16x8*)(kb + ks * 1024), qf[ks], sa0); sa1 = MFMA32(*(const LAS bf16x8*)(kb + (4 + ks) * 1024), qf[ks], sa1); }
            }
            int kslot = 1, vslot = 0;
#pragma unroll 1
            for (int c = 0; c < nc; ++c) {
                const int ks2 = (kslot == 2) ? 0 : kslot + 1;
                if (c + 2 < nc) DA_DMA_K(c + 2, ks2);
                if (c + 1 < nc) DA_DMA_V(c + 1, vslot ^ 1);
                if (c < nact) {
                    const bool nxt = c + 1 < nact;
                    const LAS unsigned char* kb = lds + DA_KOFF + kslot * DA_KS + lane * 16;
                    const LAS unsigned char* vbp = lds + DA_VOFF + vslot * DA_VS + lane * 16;
                    bf16x8 kfr[8], va[4], vn[4];
                    const int cd = c - (nc - 4);
                    if (cd >= 0) {
#pragma unroll
                        for (int i = 0; i < 16; ++i) { const int key = cd * 64 + crow(i, hh); if (key > qlim) sa0[i] = -INFINITY; if (key + 32 > qlim) sa1[i] = -INFINITY; }
                    }
                    float rm = fmaxf(sa0[0], sa1[0]);
#pragma unroll
                    for (int i = 1; i < 16; ++i) rm = fmaxf(rm, fmaxf(sa0[i], sa1[i]));
                    rm -= m;
                    if (c == 0 || __any(rm > DA_THR)) {
                        rm = fmaxf(rm, __shfl_xor(rm, 32));
                        const float dl = (c == 0) ? rm : fmaxf(rm, 0.f), alpha = __builtin_amdgcn_exp2f(-dl);
                        m += dl; l *= alpha;
                        if (c > 0) {
                            sc[r] = alpha;
#pragma unroll
                            for (int g = 0; g < 4; ++g) { const f32x4 a = *(const LAS f32x4*)(sc + 8 * g + 4 * hh);
#pragma unroll
                                for (int e = 0; e < 4; ++e) { o0[4 * g + e] *= a[e]; o1[4 * g + e] *= a[e]; o2[4 * g + e] *= a[e]; o3[4 * g + e] *= a[e]; } }
                        }
                    }
                    if (nxt) {
#pragma unroll
                        for (int f = 0; f < 8; ++f) kfr[f] = *(const LAS bf16x8*)(kb + f * 1024);
                        __builtin_amdgcn_sched_barrier(0);
                        sb0 = MFMA32(kfr[0], qf[0], zero16); sb1 = MFMA32(kfr[4], qf[0], zero16);
#pragma unroll
                        for (int ks = 1; ks < 4; ++ks) { sb0 = MFMA32(kfr[ks], qf[ks], sb0); sb1 = MFMA32(kfr[4 + ks], qf[ks], sb1); }
                    }
#pragma unroll
                    for (int f = 0; f < 4; ++f) va[f] = *(const LAS bf16x8*)(vbp + f * 1024);
                    __builtin_amdgcn_sched_barrier(0);
                    float sum = 0.f;
#pragma unroll
                    for (int i = 0; i < 16; ++i) { sa0[i] = __builtin_amdgcn_exp2f(sa0[i] - m); sa1[i] = __builtin_amdgcn_exp2f(sa1[i] - m); sum += sa0[i] + sa1[i]; }
                    l += sum;
#pragma unroll
                    for (int g = 0; g < 4; ++g) {
                        if (g < 3) {
#pragma unroll
                            for (int f = 0; f < 4; ++f) vn[f] = *(const LAS bf16x8*)(vbp + ((g + 1) * 4 + f) * 1024);
                            __builtin_amdgcn_sched_barrier(0);
                        }
                        const int s = g & 1;
                        u32x4 w;
#pragma unroll
                        for (int e = 0; e < 4; ++e) w[e] = (g >> 1) ? cvtpk(sa1[8 * s + 2 * e], sa1[8 * s + 2 * e + 1]) : cvtpk(sa0[8 * s + 2 * e], sa0[8 * s + 2 * e + 1]);
                        const bf16x8 pa = __builtin_bit_cast(bf16x8, w);
                        o0 = MFMA32(pa, va[0], o0); o1 = MFMA32(pa, va[1], o1); o2 = MFMA32(pa, va[2], o2); o3 = MFMA32(pa, va[3], o3);
#pragma unroll
                        for (int f = 0; f < 4; ++f) va[f] = vn[f];
                    }
                    sa0 = sb0; sa1 = sb1;
                }
                kslot = ks2; vslot ^= 1;
                asm volatile("s_waitcnt vmcnt(0)" ::: "memory");
                __syncthreads();
            }
#undef DA_DMA_K
#undef DA_DMA_V
            l += __shfl_xor(l, 32);
            sc[r] = 1.0f / l;
#pragma unroll
            for (int g = 0; g < 4; ++g) { const f32x4 a = *(const LAS f32x4*)(sc + 8 * g + 4 * hh);
#pragma unroll
                for (int e = 0; e < 4; ++e) { const int i = 4 * g + e; bf16_t* p = O + (tok0 + crow(i, hh)) * 1536 + vh * 128 + r;
                    p[0] = (bf16_t)f2bf(o0[i] * a[e]); p[32] = (bf16_t)f2bf(o1[i] * a[e]); p[64] = (bf16_t)f2bf(o2[i] * a[e]); p[96] = (bf16_t)f2bf(o3[i] * a[e]); } }
        }
    }
    __builtin_amdgcn_s_setprio(0);
}
constexpr size_t WS_GCNT = 896 * 1024;
constexpr size_t WS_ML = 448 * MiB, WS_GLIST = 462 * MiB;
constexpr size_t OPART_BYTES = (size_t)48 * 8192 * 64 * 2;
__device__ __forceinline__ void moba_gate_phase(const bf16_t* Q, const float* kms, int* gcnt, unsigned short* glist, LAS unsigned char* lds, int tid) {
    const int lane = tid & 63, wave = __builtin_amdgcn_readfirstlane(tid >> 6), r = lane & 31, hh = lane >> 5;
    LAS int* cnt = (LAS int*)(lds + wave * 512); LAS int* gb = cnt + 32;
    const int gw = blockIdx.x * NWAVES + wave, ngw = gridDim.x * NWAVES;
    for (int wu = gw; wu < 48 * 31 * 8; wu += ngw) {
        const int u = wu >> 3, w8 = wu & 7;
        const int cur = 31 - u / 48, bh = u % 48, b = bh / 12, h = bh % 12;
        const size_t tok0 = (size_t)b * SEQ + cur * 256 + w8 * 32;
        if (lane < 32) cnt[lane] = 0;
        bf16x8 qf[4];
#pragma unroll
        for (int ks = 0; ks < 4; ++ks) qf[ks] = *(const bf16x8*)(Q + (tok0 + r) * 768 + h * 64 + ks * 16 + hh * 8);
        f32x16 ga = {};
        const float* kr = kms + ((size_t)(bh * 32 + r)) * 64 + hh * 8;
#pragma unroll
        for (int ks = 0; ks < 4; ++ks) { const f32x4 x0 = *(const f32x4*)(kr + ks * 16), x1 = *(const f32x4*)(kr + ks * 16 + 4);
            u32x4 hi, lo;
#pragma unroll
            for (int e = 0; e < 2; ++e) { const float a0 = x0[2 * e], a1 = x0[2 * e + 1], b0 = x1[2 * e], b1 = x1[2 * e + 1];
                hi[e] = cvtpk(a0, a1); hi[2 + e] = cvtpk(b0, b1);
                lo[e] = cvtpk(a0 - bf2f(hi[e] & 0xffffu), a1 - bf2f(hi[e] >> 16)); lo[2 + e] = cvtpk(b0 - bf2f(hi[2 + e] & 0xffffu), b1 - bf2f(hi[2 + e] >> 16)); }
            ga = MFMA32(__builtin_bit_cast(bf16x8, hi), qf[ks], ga); ga = MFMA32(__builtin_bit_cast(bf16x8, lo), qf[ks], ga); }
        float v0 = -INFINITY, v1 = -INFINITY, v2 = -INFINITY; int i0 = -1, i1 = -1, i2 = -1;
#pragma unroll
        for (int i = 0; i < 16; ++i) { const int j = crow(i, hh); const float g = (j < cur) ? ga[i] : -INFINITY; TOP3_INSERT(g, j); }
        const float p0 = __shfl_xor(v0, 32), p1 = __shfl_xor(v1, 32), p2 = __shfl_xor(v2, 32); const int q0 = __shfl_xor(i0, 32), q1 = __shfl_xor(i1, 32), q2 = __shfl_xor(i2, 32);
        TOP3_INSERT(p0, q0); TOP3_INSERT(p1, q1); TOP3_INSERT(p2, q2);
        int pp0 = 0, pp1 = 0, pp2 = 0;
        if (hh == 0) { if (i0 >= 0) pp0 = atomicAdd((int*)&cnt[i0], 1); if (i1 >= 0) pp1 = atomicAdd((int*)&cnt[i1], 1); if (i2 >= 0) pp2 = atomicAdd((int*)&cnt[i2], 1); }
        if (lane < 32) { const int n = cnt[lane]; gb[lane] = n ? atomicAdd(gcnt + bh * 32 + lane, n) : 0; }
        if (hh == 0) { const int qpos = cur * 256 + w8 * 32 + r;
            if (i0 >= 0) glist[(size_t)(bh * 32 + i0) * 8192 + gb[i0] + pp0] = (unsigned short)(qpos | (0 << 13));
            if (i1 >= 0) glist[(size_t)(bh * 32 + i1) * 8192 + gb[i1] + pp1] = (unsigned short)(qpos | (1 << 13));
            if (i2 >= 0) glist[(size_t)(bh * 32 + i2) * 8192 + gb[i2] + pp2] = (unsigned short)(qpos | (2 << 13)); }
    }
}
__device__ __forceinline__ void flash_block_lds(const bf16x8 (&qf)[4], const LAS unsigned char* kb, const LAS unsigned char* vb, LAS float* sc, int lane, float& m, float& l, f32x16& o0, f32x16& o1,
                                                int nchunk, int qlim, bool masked) {
    const int hh = lane >> 5;
#pragma unroll 1
    for (int c = 0; c < nchunk; ++c) {
        const LAS unsigned char* kp = kb + c * 8192 + lane * 16; const LAS unsigned char* vp = vb + c * 8192 + lane * 16;
        f32x16 p0 = {}, p1 = {};
#pragma unroll
        for (int ks = 0; ks < 4; ++ks) { p0 = MFMA32(*(const LAS bf16x8*)(kp + ks * 1024), qf[ks], p0); p1 = MFMA32(*(const LAS bf16x8*)(kp + (4 + ks) * 1024), qf[ks], p1); }
        if (masked) { const int t0 = qlim - c * 64 - 4 * hh;
#pragma unroll
            for (int i = 0; i < 16; ++i) { const int kc = (i & 3) + 8 * (i >> 2); if (kc > t0) p0[i] = -INFINITY; if (kc + 32 > t0) p1[i] = -INFINITY; } }
        float rm = fmaxf(p0[0], p1[0]);
#pragma unroll
        for (int i = 1; i < 16; ++i) rm = fmaxf(rm, fmaxf(p0[i], p1[i]));
        if (c == 0) m = fmaxf(rm, __shfl_xor(rm, 32));
        else if (__any(rm - m > 8.0f)) {
            rm = fmaxf(rm, __shfl_xor(rm, 32));
            const float dl = fmaxf(rm - m, 0.f), alpha = __builtin_amdgcn_exp2f(-dl);
            m += dl; l *= alpha;
            sc[lane & 31] = alpha;
#pragma unroll
            for (int g = 0; g < 4; ++g) { const f32x4 a = *(const LAS f32x4*)(sc + 8 * g + 4 * hh);
#pragma unroll
                for (int e = 0; e < 4; ++e) { o0[4 * g + e] *= a[e]; o1[4 * g + e] *= a[e]; } }
        }
        float sum = 0.f;
#pragma unroll
        for (int i = 0; i < 16; ++i) { p0[i] = __builtin_amdgcn_exp2f(p0[i] - m); p1[i] = __builtin_amdgcn_exp2f(p1[i] - m); sum += p0[i] + p1[i]; }
        l += sum;
#pragma unroll
        for (int s = 0; s < 2; ++s) {
            u32x4 w0, w1;
#pragma unroll
            for (int e = 0; e < 4; ++e) { w0[e] = cvtpk(p0[8 * s + 2 * e], p0[8 * s + 2 * e + 1]); w1[e] = cvtpk(p1[8 * s + 2 * e], p1[8 * s + 2 * e + 1]); }
            const bf16x8 a0 = __builtin_bit_cast(bf16x8, w0), a1 = __builtin_bit_cast(bf16x8, w1);
            o0 = MFMA32(a0, *(const LAS bf16x8*)(vp + (s * 2 + 0) * 1024), o0); o1 = MFMA32(a0, *(const LAS bf16x8*)(vp + (s * 2 + 1) * 1024), o1);
            o0 = MFMA32(a1, *(const LAS bf16x8*)(vp + (4 + s * 2 + 0) * 1024), o0); o1 = MFMA32(a1, *(const LAS bf16x8*)(vp + (4 + s * 2 + 1) * 1024), o1);
        }
    }
}
__device__ __forceinline__ void flash_block_lds_all(const bf16x8 (&qf)[4], const LAS unsigned char* kb, const LAS unsigned char* vb, int lane, float& m, float& l, f32x16& o0, f32x16& o1) {
    const LAS unsigned char* kp = kb + lane * 16; const LAS unsigned char* vp = vb + lane * 16;
    f32x16 s[8];
#pragma unroll
    for (int t = 0; t < 8; ++t) { s[t] = (f32x16){};
#pragma unroll
        for (int ks = 0; ks < 4; ++ks) s[t] = MFMA32(*(const LAS bf16x8*)(kp + (t * 4 + ks) * 1024), qf[ks], s[t]); }
    float rm = s[0][0];
#pragma unroll
    for (int t = 0; t < 8; ++t)
#pragma unroll
        for (int i = 0; i < 16; ++i) rm = fmaxf(rm, s[t][i]);
    rm = fmaxf(rm, __shfl_xor(rm, 32));
    float sum = 0.f;
#pragma unroll
    for (int t = 0; t < 8; ++t)
#pragma unroll
        for (int i = 0; i < 16; ++i) { s[t][i] = __builtin_amdgcn_exp2f(s[t][i] - rm); sum += s[t][i]; }
    m = rm; l = sum;
#pragma unroll
    for (int t = 0; t < 8; ++t)
#pragma unroll
        for (int h2 = 0; h2 < 2; ++h2) {
            u32x4 w;
#pragma unroll
            for (int e = 0; e < 4; ++e) w[e] = cvtpk(s[t][8 * h2 + 2 * e], s[t][8 * h2 + 2 * e + 1]);
            const bf16x8 pa = __builtin_bit_cast(bf16x8, w);
            o0 = MFMA32(pa, *(const LAS bf16x8*)(vp + ((t * 2 + h2) * 2 + 0) * 1024), o0); o1 = MFMA32(pa, *(const LAS bf16x8*)(vp + ((t * 2 + h2) * 2 + 1) * 1024), o1);
        }
}
constexpr int KS_K = 0, KS_V = 32768, KS_SCR = 65536, KS_TILE = 65536 + 8 * 512;
__device__ __forceinline__ void moba_keyblock_phase(const bf16_t* Q, const bf16_t* Kf, const bf16_t* Vf, const int* gcnt, const unsigned short* glist,
                                                    bf16_t* op0, bf16_t* op1, bf16_t* op2, float* ml, bf16_t* att, LAS unsigned char* lds, int tid) {
    const int lane = tid & 63, wave = __builtin_amdgcn_readfirstlane(tid >> 6), r = lane & 31, hh = lane >> 5;
    LAS float* sc = (LAS float*)(lds + KS_SCR + wave * 512); LAS int* sci = (LAS int*)(sc + 32);
    if (wave >= 4) __builtin_amdgcn_s_setprio(1);
    for (int u = blockIdx.x; u < 48 * 32; u += gridDim.x) {
        const int j = u / 48, bh = u % 48, b = bh / 12, h = bh % 12;
        const int n = (j < 31) ? gcnt[bh * 32 + j] : 0;
        {
            const bf16_t* ks = Kf + (size_t)bh * (SEQ * 64) + (size_t)j * (256 * 64) + tid * 8; const bf16_t* vs = Vf + (size_t)bh * (SEQ * 64) + (size_t)j * (256 * 64) + tid * 8;
            u32x4 a[4], c[4];
#pragma unroll
            for (int i = 0; i < 4; ++i) { a[i] = *(const u32x4*)(ks + i * 4096); c[i] = *(const u32x4*)(vs + i * 4096); }
#pragma unroll
            for (int i = 0; i < 4; ++i) { *(LAS u32x4*)(lds + KS_K + (tid + 512 * i) * 16) = a[i]; *(LAS u32x4*)(lds + KS_V + (tid + 512 * i) * 16) = c[i]; }
        }
        __syncthreads();
        const unsigned short* gl = glist + (size_t)(bh * 32 + j) * 8192;
        const int nit = (n + 31) >> 5;
        LAS bf16_t* tile = (LAS bf16_t*)(lds + KS_TILE + wave * 4096);
        {
            const int qpos = j * 256 + wave * 32 + r;
            bf16x8 qo[4];
#pragma unroll
            for (int ks = 0; ks < 4; ++ks) qo[ks] = *(const bf16x8*)(Q + ((size_t)b * SEQ + qpos) * 768 + h * 64 + ks * 16 + hh * 8);
            float m = -INFINITY, l = 0.f; f32x16 o0 = {}, o1 = {};
            flash_block_lds(qo, lds + KS_K, lds + KS_V, sc, lane, m, l, o0, o1, (wave >> 1) + 1, wave * 32 + r, true);
            l += __shfl_xor(l, 32);
#pragma unroll
            for (int i = 0; i < 16; ++i) { const int row = crow(i, hh); tile[row * 64 + r] = (bf16_t)f2bf(o0[i]); tile[row * 64 + 32 + r] = (bf16_t)f2bf(o1[i]); }
#pragma unroll
            for (int q = 0; q < 4; ++q) { const int row = q * 8 + (lane >> 3), ch = lane & 7;
                *(u32x4*)(att + ((size_t)b * SEQ + j * 256 + wave * 32 + row) * 1024 + h * 64 + ch * 8) = *(const LAS u32x4*)(tile + row * 64 + ch * 8); }
            if (hh == 0) { float* pm = ml + ((size_t)3 * (48 * 8192) + (size_t)bh * 8192 + qpos) * 2; pm[0] = m; pm[1] = l; }
        }
        int e0 = 0, e1 = 0; bf16x8 qf[4];
        const int w0 = NWAVES - 1 - wave;
        if (w0 < nit) { const int p = w0 * 32 + r; e0 = gl[p < n ? p : n - 1];
#pragma unroll
            for (int ks = 0; ks < 4; ++ks) qf[ks] = *(const bf16x8*)(Q + ((size_t)b * SEQ + (e0 & 8191)) * 768 + h * 64 + ks * 16 + hh * 8); }
        if (w0 + NWAVES < nit) { const int p = (w0 + NWAVES) * 32 + r; e1 = gl[p < n ? p : n - 1]; }
        for (int it = w0; it < nit; it += NWAVES) {
            const bool valid = it * 32 + r < n; const int e = e0, qpos = e & 8191, slot = e >> 13;
            const bool more = it + NWAVES < nit;
            bf16x8 qn[4]; int e2 = 0;
            if (more) {
#pragma unroll
                for (int ks = 0; ks < 4; ++ks) qn[ks] = *(const bf16x8*)(Q + ((size_t)b * SEQ + (e1 & 8191)) * 768 + h * 64 + ks * 16 + hh * 8);
                if (it + 2 * NWAVES < nit) { const int p = (it + 2 * NWAVES) * 32 + r; e2 = gl[p < n ? p : n - 1]; }
            } else {
#pragma unroll
                for (int ks = 0; ks < 4; ++ks) qn[ks] = qf[ks];
            }
            float m = -INFINITY, l = 0.f; f32x16 o0 = {}, o1 = {};
            flash_block_lds_all(qf, lds + KS_K, lds + KS_V, lane, m, l, o0, o1);
            l += __shfl_xor(l, 32);
            sci[r] = valid ? e : -1;
#pragma unroll
            for (int i = 0; i < 16; ++i) { const int row = crow(i, hh); tile[row * 64 + r] = (bf16_t)f2bf(o0[i]); tile[row * 64 + 32 + r] = (bf16_t)f2bf(o1[i]); }
#pragma unroll
            for (int q = 0; q < 4; ++q) { const int row = q * 8 + (lane >> 3), ch = lane & 7; const int id = sci[row];
                const u32x4 v = *(const LAS u32x4*)(tile + row * 64 + ch * 8);
                if (id >= 0) { const int sl = id >> 13; bf16_t* base = sl == 0 ? op0 : (sl == 1 ? op1 : op2);
                    *(u32x4*)(base + ((size_t)bh * 8192 + (id & 8191)) * 64 + ch * 8) = v; } }
            if (valid && hh == 0) { float* pm = ml + ((size_t)slot * (48 * 8192) + (size_t)bh * 8192 + qpos) * 2; pm[0] = m; pm[1] = l; }
            e0 = e1; e1 = e2;
#pragma unroll
            for (int ks = 0; ks < 4; ++ks) qf[ks] = qn[ks];
        }
        __syncthreads();
    }
    __builtin_amdgcn_s_setprio(0);
}
__device__ __forceinline__ void moba_merge_phase(const bf16_t* op0, const bf16_t* op1, const bf16_t* op2, const float* ml, bf16_t* att, int gw, int ngw, int lane) {
    typedef float f32x2m __attribute__((ext_vector_type(2)));
    for (int it = gw; it < 48 * 8192 / 32; it += ngw) {
        const int bh = it >> 8, q0 = (it & 255) * 32, b = bh / 12, h = bh % 12, cur = q0 >> 8, nv = cur < 3 ? cur : 3;
        u32x4 ov[4], pv[4][3]; f32x2m mo[4], mp[4][3];
#pragma unroll
        for (int q = 0; q < 4; ++q) { const int row = q * 8 + (lane >> 3), ch = lane & 7, qp = q0 + row; const size_t qrow = (size_t)bh * 8192 + qp;
            ov[q] = *(const u32x4*)(att + ((size_t)b * SEQ + qp) * 1024 + h * 64 + ch * 8);
            mo[q] = *(const f32x2m*)(ml + ((size_t)3 * (48 * 8192) + qrow) * 2);
#pragma unroll
            for (int k = 0; k < 3; ++k) { if (k < nv) { const bf16_t* ob = k == 0 ? op0 : (k == 1 ? op1 : op2); pv[q][k] = *(const u32x4*)(ob + qrow * 64 + ch * 8); mp[q][k] = *(const f32x2m*)(ml + ((size_t)k * (48 * 8192) + qrow) * 2); }
                                          else { pv[q][k] = (u32x4){0u, 0u, 0u, 0u}; mp[q][k] = (f32x2m){-INFINITY, 0.f}; } } }
#pragma unroll
        for (int q = 0; q < 4; ++q) { const int row = q * 8 + (lane >> 3), ch = lane & 7, qp = q0 + row;
            float M = mo[q][0];
#pragma unroll
            for (int k = 0; k < 3; ++k) M = fmaxf(M, mp[q][k][0]);
            const float wo = __builtin_amdgcn_exp2f(mo[q][0] - M); float L = wo * mo[q][1], wk[3];
#pragma unroll
            for (int k = 0; k < 3; ++k) { wk[k] = (k < nv) ? __builtin_amdgcn_exp2f(mp[q][k][0] - M) : 0.f; L += wk[k] * mp[q][k][1]; }
            const float invL = 1.0f / L, ao = wo * invL;
            f32x4 x0, x1;
            x0[0] = bf2f(ov[q].x & 0xffffu) * ao; x0[1] = bf2f(ov[q].x >> 16) * ao; x0[2] = bf2f(ov[q].y & 0xffffu) * ao; x0[3] = bf2f(ov[q].y >> 16) * ao;
            x1[0] = bf2f(ov[q].z & 0xffffu) * ao; x1[1] = bf2f(ov[q].z >> 16) * ao; x1[2] = bf2f(ov[q].w & 0xffffu) * ao; x1[3] = bf2f(ov[q].w >> 16) * ao;
#pragma unroll
            for (int k = 0; k < 3; ++k) { const float a = wk[k] * invL; const u32x4 p = pv[q][k];
                x0[0] += bf2f(p.x & 0xffffu) * a; x0[1] += bf2f(p.x >> 16) * a; x0[2] += bf2f(p.y & 0xffffu) * a; x0[3] += bf2f(p.y >> 16) * a;
                x1[0] += bf2f(p.z & 0xffffu) * a; x1[1] += bf2f(p.z >> 16) * a; x1[2] += bf2f(p.w & 0xffffu) * a; x1[3] += bf2f(p.w >> 16) * a; }
            u32x4 o; o.x = cvtpk(x0[0], x0[1]); o.y = cvtpk(x0[2], x0[3]); o.z = cvtpk(x1[0], x1[1]); o.w = cvtpk(x1[2], x1[3]);
            *(u32x4*)(att + ((size_t)b * SEQ + qp) * 1024 + h * 64 + ch * 8) = o; }
    }
}
__device__ __forceinline__ void mem_attn_lds_phase(const bf16_t* QM, const bf16_t* MK, const bf16_t* MV, bf16_t* att, LAS unsigned char* lds, int tid) {
    const int lane = tid & 63, wave = __builtin_amdgcn_readfirstlane(tid >> 6), r = lane & 31, hh = lane >> 5;
    LAS float* sc = (LAS float*)(lds + KS_SCR + wave * 512); LAS bf16_t* tile = (LAS bf16_t*)(lds + KS_TILE + wave * 4096);
    for (int u = blockIdx.x; u < 256; u += gridDim.x) {
        const int bhd = u >> 4, b = bhd >> 2, head = bhd & 3, part = u & 15;
        {   const bf16_t* ks = MK + (size_t)bhd * (256 * 64) + tid * 8; const bf16_t* vs = MV + (size_t)bhd * (256 * 64) + tid * 8;
            u32x4 a[4], c[4];
#pragma unroll
            for (int i = 0; i < 4; ++i) { a[i] = *(const u32x4*)(ks + i * 4096); c[i] = *(const u32x4*)(vs + i * 4096); }
#pragma unroll
            for (int i = 0; i < 4; ++i) { *(LAS u32x4*)(lds + KS_K + (tid + 512 * i) * 16) = a[i]; *(LAS u32x4*)(lds + KS_V + (tid + 512 * i) * 16) = c[i]; }
        }
        __syncthreads();
#pragma unroll 1
        for (int k = 0; k < 2; ++k) {
            const size_t row0 = (size_t)b * SEQ + (size_t)(part * 16 + k * 8 + wave) * 32;
            bf16x8 qf[4];
#pragma unroll
            for (int ks = 0; ks < 4; ++ks) qf[ks] = *(const bf16x8*)(QM + (row0 + r) * 256 + head * 64 + ks * 16 + hh * 8);
            float m = -INFINITY, l = 0.f; f32x16 o0 = {}, o1 = {};
            flash_block_lds_all(qf, lds + KS_K, lds + KS_V, lane, m, l, o0, o1);
            l += __shfl_xor(l, 32);
            sc[r] = 1.0f / l;
#pragma unroll
            for (int g = 0; g < 4; ++g) { const f32x4 a = *(const LAS f32x4*)(sc + 8 * g + 4 * hh);
#pragma unroll
                for (int e = 0; e < 4; ++e) { const int i = 4 * g + e, row = crow(i, hh); tile[row * 64 + r] = (bf16_t)f2bf(o0[i] * a[e]); tile[row * 64 + 32 + r] = (bf16_t)f2bf(o1[i] * a[e]); } }
#pragma unroll
            for (int q = 0; q < 4; ++q) { const int row = q * 8 + (lane >> 3), ch = lane & 7;
                *(u32x4*)(att + (row0 + row) * 1024 + 768 + head * 64 + ch * 8) = *(const LAS u32x4*)(tile + row * 64 + ch * 8); }
        }
        __syncthreads();
    }
}
#define XB_TMO      128
#define XB_XCNT(j)  (256  + 64 * (j))
#define XB_XSUB(j)  (1280 + 64 * (j))
#define XB_XGEN(j)  (2304 + 64 * (j))
#define XB_TOP      3328
#define XB_TOPGEN   3392
#define XCD_BAR_WORDS 3456
#define XB_SPIN_CAP (1u << 18)

__device__ __forceinline__ unsigned xb_ld(unsigned* p)              { return __hip_atomic_load(p, __ATOMIC_RELAXED, __HIP_MEMORY_SCOPE_AGENT); }
__device__ __forceinline__ unsigned xb_add(unsigned* p, unsigned v) { return __hip_atomic_fetch_add(p, v, __ATOMIC_RELAXED, __HIP_MEMORY_SCOPE_AGENT); }
__device__ __forceinline__ unsigned xb_xcc_id() { return (unsigned)__builtin_amdgcn_s_getreg((3 << 11) | 20) & 0xFu; }
#define XB_SPIN(cond, bar) do { unsigned _sp = 0; while (cond) { __builtin_amdgcn_s_sleep(1); \
    if ((++_sp & 255u) == 0u) { if (xb_ld(&(bar)[XB_TMO])) break; if (_sp > XB_SPIN_CAP) { atomicAdd(&(bar)[XB_TMO], 1u); break; } } } } while (0)

struct XcdBarrier {
    unsigned* bar; unsigned x;
    volatile LAS unsigned* st;
};

__device__ __forceinline__ XcdBarrier xcd_barrier_post(unsigned* bar, volatile LAS unsigned* st) {
    XcdBarrier b; b.bar = bar; b.x = xb_xcc_id(); b.st = st;
    if (threadIdx.x == 0) (void)xb_add(&bar[XB_XCNT(b.x)], 1u);
    return b;
}
__device__ __forceinline__ void xcd_barrier_complete(unsigned* bar, unsigned x, unsigned& nloc, unsigned& nx) {
    const unsigned G = gridDim.x * gridDim.y * gridDim.z;
    unsigned sum, cnt, mine, sp = 0u;
    for (;;) {
        sum = 0u; cnt = 0u; mine = 0u;
#pragma unroll
        for (unsigned j = 0; j < 16; ++j) { const unsigned c = xb_ld(&bar[XB_XCNT(j)]); sum += c; cnt += (c > 0u) ? 1u : 0u; mine = (j == x) ? c : mine; }
        if (sum == G) break;
        __builtin_amdgcn_s_sleep(1);
        if ((++sp & 255u) == 0u) { if (xb_ld(&bar[XB_TMO])) break; if (sp > XB_SPIN_CAP) { atomicAdd(&bar[XB_TMO], 1u); break; } }
    }
    nloc = mine > 0u ? mine : 1u; nx = cnt > 0u ? cnt : 1u;
}

__device__ __forceinline__ void xcd_barrier(const XcdBarrier& b) {
    asm volatile("s_waitcnt vmcnt(0)" ::: "memory");
    __syncthreads();
    if (threadIdx.x == 0) {
        unsigned* bar = b.bar;
        __builtin_amdgcn_s_waitcnt(0);
        unsigned nloc = b.st[0], nx = b.st[1];
        if (nloc == 0u) { xcd_barrier_complete(bar, b.x, nloc, nx); b.st[0] = nloc; b.st[1] = nx; }
        const unsigned old = xb_add(&bar[XB_XSUB(b.x)], 1u);
        const unsigned gen = old / nloc;
        if (old + 1u == (gen + 1u) * nloc) {
            __builtin_amdgcn_fence(__ATOMIC_RELEASE, "agent");
            asm volatile("s_waitcnt vmcnt(0)" ::: "memory");
            const unsigned og = xb_add(&bar[XB_TOP], 1u);
            const unsigned tg = og / nx;
            if (og + 1u == (tg + 1u) * nx) xb_add(&bar[XB_TOPGEN], 1u);
            else XB_SPIN(xb_ld(&bar[XB_TOPGEN]) == tg, bar);
            __builtin_amdgcn_fence(__ATOMIC_ACQUIRE, "agent");
            xb_add(&bar[XB_XGEN(b.x)], 1u);
            asm volatile("s_waitcnt vmcnt(0)" ::: "memory");
        } else {
            XB_SPIN(xb_ld(&bar[XB_XGEN(b.x)]) == gen, bar);
            __builtin_amdgcn_fence(__ATOMIC_ACQUIRE, "agent");
            asm volatile("s_waitcnt vmcnt(0)" ::: "memory");
        }
    }
    __syncthreads();
}

#define CONVERT_WEIGHTS(IT_LO, IT_HI) do { \
        LAS float* scr = (LAS float*)(L + wave * 16384); \
        LAS unsigned long long* T = (LAS unsigned long long*)(L + 132096); \
        _Pragma("unroll") \
        for (int k = 0; k < NWD; ++k) if (tid == k) { T[k * 8 + 0] = (unsigned long long)P.wd[k].src; T[k * 8 + 1] = (unsigned long long)P.wd[k].gain; T[k * 8 + 2] = (unsigned long long)P.wd[k].dst; \
            T[k * 8 + 3] = (unsigned)P.wd[k].K | ((unsigned long long)(unsigned)P.wd[k].N << 32); T[k * 8 + 4] = (unsigned)P.wd[k].col0 | ((unsigned long long)(unsigned)P.wd[k].ncols << 32); \
            T[k * 8 + 5] = (unsigned)P.wd[k].rowoff | ((unsigned long long)(unsigned)P.wd[k].perm << 32); T[k * 8 + 6] = (unsigned)P.wd[k].start; } \
        __syncthreads(); \
        for (int it = IT_LO + gw; it < IT_HI; it += ngw) { \
            int k = 0; \
            for (int j = 1; j < NWD; ++j) if (it >= (int)(unsigned)T[j * 8 + 6]) k = j; \
            k = __builtin_amdgcn_readfirstlane(k); \
            WDesc w; w.src = (const float*)(GAS const float*)rfl64(T[k * 8 + 0]); w.gain = (const float*)(GAS const float*)rfl64(T[k * 8 + 1]); w.dst = (bf16_t*)(GAS bf16_t*)rfl64(T[k * 8 + 2]); \
            { const unsigned long long a = rfl64(T[k * 8 + 3]), b = rfl64(T[k * 8 + 4]), c = rfl64(T[k * 8 + 5]), d = rfl64(T[k * 8 + 6]); \
              w.K = (int)(unsigned)a; w.N = (int)(a >> 32); w.col0 = (int)(unsigned)b; w.ncols = (int)(b >> 32); w.rowoff = (int)(unsigned)c; w.perm = (int)(c >> 32); w.start = (int)(unsigned)d; w.pad = 0; } \
            p0_transpose_item(w, scr, it - w.start, lane); \
        } \
        __syncthreads(); \
    } while (0)
__global__ void __launch_bounds__(NTHREADS, 2) fwd_kernel(Params P) {
    extern __shared__ __attribute__((aligned(16))) unsigned char lds[];
    cg::grid_group grid = cg::this_grid();
    LAS unsigned char* L = (LAS unsigned char*)lds;
    volatile LAS unsigned* bst = (volatile LAS unsigned*)(L + LDS_BYTES - 64);
    if (threadIdx.x < 2) bst[threadIdx.x] = 0u;
    __syncthreads();
    const XcdBarrier xbar = xcd_barrier_post((unsigned*)(P.ws + WS_BAR), bst);
#ifdef PROBE_K
#define STAMP(k) do { if (bx == 0 && tid == 0) ((unsigned long long*)(ws + WS_SS0 + 256 * 1024))[k] = __builtin_amdgcn_s_memrealtime(); } while (0)
#else
#define STAMP(k) do { } while (0)
#endif
#define PHASE_PTRS \
    int tid = threadIdx.x; asm volatile("" : "+v"(tid)); const int lane = tid & 63, wave = __builtin_amdgcn_readfirstlane(tid >> 6); \
    const int G = gridDim.x, bx = blockIdx.x, gw = bx * NWAVES + wave, ngw = G * NWAVES, gtid = bx * NTHREADS + tid, nthr = G * NTHREADS; \
    (void)lane; (void)gw; (void)ngw; (void)gtid; (void)nthr; \
    GAS unsigned char* wsg_; { GAS unsigned char* t_ = (GAS unsigned char*)rfl64((unsigned long long)P.ws); asm volatile("" : "=s"(wsg_) : "0"(t_)); } unsigned char* ws = (unsigned char*)wsg_; \
    float* ss1 = (float*)(ws + WS_SS); float* ss2 = ss1 + MTOK; float* ss3 = ss2 + MTOK; float* ss4 = ss3 + MTOK; (void)ss1; (void)ss2; (void)ss3; (void)ss4; \
    float* kms = (float*)(ws + WS_KMS); float* ss0 = (float*)(ws + WS_SS0); float* ssm = (float*)(ws + WS_SSM); (void)kms; (void)ss0; (void)ssm; \
    float* cosT = (float*)(ws + WS_COS); float* sinT = (float*)(ws + WS_SIN); (void)cosT; (void)sinT; \
    bf16_t* WA_in = (bf16_t*)(ws + WS_WA_IN); bf16_t* WA_v = (bf16_t*)(ws + WS_WA_V); (void)WA_v; bf16_t* WA_out = (bf16_t*)(ws + WS_WA_OUT); bf16_t* WA_up = (bf16_t*)(ws + WS_WA_UP); bf16_t* WA_down = (bf16_t*)(ws + WS_WA_DOWN); \
    bf16_t* WB_in = (bf16_t*)(ws + WS_WB_IN); bf16_t* WB_v = (bf16_t*)(ws + WS_WB_V); bf16_t* WB_out = (bf16_t*)(ws + WS_WB_OUT); bf16_t* WB_up = (bf16_t*)(ws + WS_WB_UP); bf16_t* WB_down = (bf16_t*)(ws + WS_WB_DOWN); \
    bf16_t* WA_mem = (bf16_t*)(ws + WS_WA_MEM); bf16_t* WB_mem = (bf16_t*)(ws + WS_WB_MEM); bf16_t* mem16 = (bf16_t*)(ws + WS_MEM16); \
    bf16_t* MKA = (bf16_t*)(ws + WS_MKA); bf16_t* MVA = (bf16_t*)(ws + WS_MVA); bf16_t* MKB = (bf16_t*)(ws + WS_MKB); bf16_t* MVB = (bf16_t*)(ws + WS_MVB); \
    bf16_t* x16 = (bf16_t*)(ws + WS_X16); bf16_t* att = (bf16_t*)(ws + WS_ATT); unsigned char* big = ws + WS_BIG; \
    bf16_t* QA = (bf16_t*)(big + BG_QA); bf16_t* KA = (bf16_t*)(big + BG_KA); bf16_t* VA = (bf16_t*)(big + BG_VA); bf16_t* OA = (bf16_t*)(big + BG_OA); bf16_t* QMA = (bf16_t*)(big + BG_QMA); \
    bf16_t* QB = (bf16_t*)(big + BG_QB); bf16_t* KBf = (bf16_t*)(big + BG_KB); bf16_t* VBf = (bf16_t*)(big + BG_VB); bf16_t* QMB = (bf16_t*)(big + BG_QMB); bf16_t* H = (bf16_t*)big; \
    (void)WA_in; (void)WA_out; (void)WA_up; (void)WA_down; (void)WB_in; (void)WB_v; (void)WB_out; (void)WB_up; (void)WB_down; (void)WA_mem; (void)WB_mem; (void)mem16; (void)MKA; (void)MVA; (void)MKB; (void)MVB; \
    (void)x16; (void)att; (void)QA; (void)KA; (void)VA; (void)OA; (void)QMA; (void)QB; (void)KBf; (void)VBf; (void)QMB; (void)H; \
    LAS float* wsc = (LAS float*)(L + wave * 512); (void)wsc;

    { PHASE_PTRS STAMP(0);
        for (int i = gtid; i < 57344 + 384; i += nthr) ((u32x4*)ws)[i] = (u32x4){0u, 0u, 0u, 0u};
        { float myinv = 0.f;
#pragma unroll
            for (int d = 0; d < 32; ++d) myinv = ((lane & 31) == d) ? P.inv[d] : myinv;
            for (int e = gtid; e < SEQ * 32; e += nthr) { float s, c; sincos_acc((float)(e >> 5) * myinv, s, c); cosT[e] = c; sinT[e] = s; } }
        for (int m = gw; m + 3 * ngw < MTOK; m += 4 * ngw) rows_to_bf16<4>(P.x + (size_t)m * DM, x16 + (size_t)m * DM, ss0 + m, (size_t)ngw, lane);
        for (int m = gw; m < MEMROWS; m += ngw) rows_to_bf16<1>(P.mem + (size_t)m * DM, mem16 + (size_t)m * DM, ssm + m, 0, lane);
        CONVERT_WEIGHTS(0, P.nearly);
    }
    if (P.nitems == 0x7fffffff) grid.sync();
    xcd_barrier(xbar);
    { PHASE_PTRS STAMP(1);
        { pg8::Gemm g{x16, WA_in, MTOK, 1792, DM}; pg8::StaticOrder S; S.init(MTOK, 1792, G, bx);
          pg8::EpiInB E{KA, QA, QMA, nullptr, ss0, cosT, sinT, C2}; pg8::gemm_phase<pg8::EpiInB, pg8::StaticOrder, true, true>(L, g, S, E); }
        { pg8::Gemm g{WA_v, x16, 768, MTOK, DM}; pg8::StaticOrder S; S.init(768, MTOK, G, (bx + G / 2) % G);
          pg8::EpiVt<13, 6, 7> E{VA, ss0}; pg8::gemm_phase<pg8::EpiVt<13, 6, 7>, pg8::StaticOrder, true, true>(L, g, S, E); }
        { pg8::Gemm g{mem16, WA_mem, MEMROWS, 256, DM}; pg8::StaticOrder S; S.init(MEMROWS, 256, G, bx);
          pg8::EpiMemK E{MKA, ssm}; pg8::gemm_phase<pg8::EpiMemK, pg8::StaticOrder, true, true>(L, g, S, E); }
        { pg8::Gemm g{mem16, WB_mem, MEMROWS, 256, DM}; pg8::StaticOrder S; S.init(MEMROWS, 256, G, (bx + G - 4) % G);
          pg8::EpiMemK E{MKB, ssm}; pg8::gemm_phase<pg8::EpiMemK, pg8::StaticOrder, true, true>(L, g, S, E); }
        { pg8::Gemm g{WA_mem + 256 * DM, mem16, 256, MEMROWS, DM}; pg8::StaticOrder S; S.init(256, MEMROWS, G, (bx + G - 8) % G);
          pg8::EpiVt<8, 4, 6> E{MVA, ssm}; pg8::gemm_phase<pg8::EpiVt<8, 4, 6>, pg8::StaticOrder, true, true>(L, g, S, E); }
        { pg8::Gemm g{WB_mem + 256 * DM, mem16, 256, MEMROWS, DM}; pg8::StaticOrder S; S.init(256, MEMROWS, G, (bx + G - 12) % G);
          pg8::EpiVt<8, 4, 6> E{MVB, ssm}; pg8::gemm_phase<pg8::EpiVt<8, 4, 6>, pg8::StaticOrder, true, true>(L, g, S, E); }
    }
    xcd_barrier(xbar);
    { PHASE_PTRS STAMP(2);
        mem_attn_lds_phase(QMA, MKA, MVA, att, L, tid);
        __syncthreads();
        diff_attn_phase(QA, KA, VA, OA, L, tid);
        __syncthreads();
    }
    { PHASE_PTRS CONVERT_WEIGHTS(P.nearly, P.nitems); }
    xcd_barrier(xbar);
    { PHASE_PTRS STAMP(3); diff_combine_phase(OA, P.a_lambda, P.a_subln, att, gw, ngw, lane); }
    xcd_barrier(xbar);
    { PHASE_PTRS STAMP(4); pg8::Gemm g{att, WA_out, MTOK, DM, DM}; pg8::StaticOrder S; S.init(MTOK, DM, G, bx);
      pg8::EpiRes<true, false> E{P.x, x16, ss1, nullptr}; pg8::gemm_phase<pg8::EpiRes<true, false>, pg8::StaticOrder, true, true>(L, g, S, E); }
    xcd_barrier(xbar);
    { PHASE_PTRS STAMP(5); pg8::Gemm g{x16, WA_up, MTOK, FF, DM}; pg8::StaticOrder S; S.init(MTOK, FF, G, bx);
      pg8::EpiUp E{H}; pg8::gemm_phase<pg8::EpiUp, pg8::StaticOrder, true, true>(L, g, S, E); }
    xcd_barrier(xbar);
    { PHASE_PTRS STAMP(6); pg8::Gemm g{H, WA_down, MTOK, DM, FF}; pg8::StaticOrder S; S.init(MTOK, DM, G, bx);
      pg8::EpiRes<false, true> E{nullptr, x16, ss2, ss1}; pg8::gemm_phase<pg8::EpiRes<false, true>, pg8::StaticOrder, true, true>(L, g, S, E); }
    xcd_barrier(xbar);
    { PHASE_PTRS STAMP(7);
        { pg8::Gemm g{x16, WB_in, MTOK, 1792, DM}; pg8::StaticOrder S; S.init(MTOK, 1792, G, bx);
          pg8::EpiInB E{KBf, QB, QMB, kms, ss2, cosT, sinT, C2}; pg8::gemm_phase<pg8::EpiInB, pg8::StaticOrder, true, true>(L, g, S, E); }
        { pg8::Gemm g{WB_v, x16, 768, MTOK, DM}; pg8::StaticOrder S; S.init(768, MTOK, G, (bx + G / 2) % G);
          pg8::EpiVt<13, 12, 6> E{VBf, ss2}; pg8::gemm_phase<pg8::EpiVt<13, 12, 6>, pg8::StaticOrder, true, true>(L, g, S, E); }
    }
    xcd_barrier(xbar);
    { PHASE_PTRS STAMP(8);
        mem_attn_lds_phase(QMB, MKB, MVB, att, L, tid);
        __syncthreads();
        moba_gate_phase(QB, kms, (int*)(ws + WS_GCNT), (unsigned short*)(ws + WS_GLIST), L, tid);
    }
    xcd_barrier(xbar);
    { PHASE_PTRS STAMP(13);
        bf16_t* op0 = (bf16_t*)P.out; bf16_t* op1 = (bf16_t*)((unsigned char*)P.out + OPART_BYTES); bf16_t* op2 = (bf16_t*)(big + 160 * MiB);
        moba_keyblock_phase(QB, KBf, VBf, (const int*)(ws + WS_GCNT), (const unsigned short*)(ws + WS_GLIST), op0, op1, op2, (float*)(ws + WS_ML), att, L, tid);
    }
    xcd_barrier(xbar);
    { PHASE_PTRS STAMP(14);
        const bf16_t* op0 = (const bf16_t*)P.out; const bf16_t* op1 = (const bf16_t*)((const unsigned char*)P.out + OPART_BYTES); const bf16_t* op2 = (const bf16_t*)(big + 160 * MiB);
        moba_merge_phase(op0, op1, op2, (const float*)(ws + WS_ML), att, gw, ngw, lane);
    }
    xcd_barrier(xbar);
    { PHASE_PTRS STAMP(9); pg8::Gemm g{att, WB_out, MTOK, DM, DM}; pg8::StaticOrder S; S.init(MTOK, DM, G, bx);
      pg8::EpiRes<false, false> E{nullptr, x16, ss3, nullptr}; pg8::gemm_phase<pg8::EpiRes<false, false>, pg8::StaticOrder, true, true>(L, g, S, E); }
    xcd_barrier(xbar);
    { PHASE_PTRS STAMP(10); pg8::Gemm g{x16, WB_up, MTOK, FF, DM}; pg8::StaticOrder S; S.init(MTOK, FF, G, bx);
      pg8::EpiUp E{H}; pg8::gemm_phase<pg8::EpiUp, pg8::StaticOrder, true, true>(L, g, S, E); }
    xcd_barrier(xbar);
    { PHASE_PTRS STAMP(11); pg8::Gemm g{H, WB_down, MTOK, DM, FF}; pg8::StaticOrder S; S.init(MTOK, DM, G, bx);
      pg8::EpiRes<false, true> E{nullptr, x16, ss4, ss3}; pg8::gemm_phase<pg8::EpiRes<false, true>, pg8::StaticOrder, true, true>(L, g, S, E); }
    xcd_barrier(xbar);
    { PHASE_PTRS STAMP(12);
    for (int m0 = gw; m0 + 3 * ngw < MTOK; m0 += 4 * ngw) {
        u32x2 w[4][4]; float rs[4];
#pragma unroll
        for (int q = 0; q < 4; ++q) { const int m = m0 + q * ngw; rs[q] = rstd_of(ss4[m]); const u32x2* xb = (const u32x2*)(x16 + (size_t)m * DM) + lane;
#pragma unroll
            for (int j = 0; j < 4; ++j) w[q][j] = xb[64 * j]; }
        const f32x4* gr = (const f32x4*)P.final_norm + lane;
#pragma unroll
        for (int q = 0; q < 4; ++q) { const int m = m0 + q * ngw; f32x4* xr = (f32x4*)(P.out + (size_t)m * DM) + lane;
#pragma unroll
            for (int j = 0; j < 4; ++j) { f32x4 v; v[0] = __builtin_bit_cast(float, w[q][j].x << 16); v[1] = __builtin_bit_cast(float, w[q][j].x & 0xffff0000u); v[2] = __builtin_bit_cast(float, w[q][j].y << 16); v[3] = __builtin_bit_cast(float, w[q][j].y & 0xffff0000u);
                v = v * rs[q] * gr[64 * j];
#ifdef PROBE_K
                if (m < 4096) { const unsigned long long* st = (const unsigned long long*)(ws + WS_SS0 + 256 * 1024);
                    const float f = (PROBE_K == 9999) ? 1.0f : (float)(st[PROBE_K % 100] - st[PROBE_K / 100]) / (float)(st[11] - st[0]); v = v + 0.04f * f; }
#endif
                xr[64 * j] = v; } }
    } }
}

extern "C" void kernel_launch(void* const* d_in, const int* in_sizes, int n_in, void* d_out, int out_size, void* d_ws, size_t ws_size, hipStream_t stream) {
    static int ready = 0;
    if (ready == 0) {
        ready = -1;
        if (n_in != 23 || in_sizes[0] != MTOK * DM || out_size != MTOK * DM || ws_size < WS_END) { fprintf(stderr, "kernel_launch: unexpected shapes / workspace (n_in %d, ws %zu)\n", n_in, ws_size); return; }
        if (hipFuncSetAttribute((const void*)fwd_kernel, hipFuncAttributeMaxDynamicSharedMemorySize, LDS_BYTES) != hipSuccess) { fprintf(stderr, "kernel_launch: hipFuncSetAttribute failed\n"); return; }
        ready = 1;
    }
    if (ready < 0) return;
    Params p{};
    p.x = (const float*)d_in[0]; p.mem = (const float*)d_in[1]; p.a_lambda = (const float*)d_in[4]; p.a_subln = (const float*)d_in[5]; p.final_norm = (const float*)d_in[22];
    p.out = (float*)d_out; p.ws = (unsigned char*)d_ws;
    unsigned char* ws = (unsigned char*)d_ws;
    auto F = [&](int i) { return (const float*)d_in[i]; };
    auto B = [&](size_t off) { return (bf16_t*)(ws + off); };
    const WDesc wd[NWD] = {
        {F(3),  F(2),  B(WS_WA_IN),   1024, 2560, 768,  768,  0,    1, 0, 0},
        {F(3),  F(2),  B(WS_WA_IN),   1024, 2560, 0,    768,  768,  1, 0, 0},
        {F(3),  F(2),  B(WS_WA_IN),   1024, 2560, 2304, 256,  1536, 0, 0, 0},
        {F(3),  F(2),  B(WS_WA_V),    1024, 2560, 1536, 768,  0,    0, 0, 0},
        {F(7),  F(6),  B(WS_WA_MEM),  1024, 512,  0,    512,  0,    0, 0, 0},
        {F(17), F(16), B(WS_WB_MEM),  1024, 512,  0,    512,  0,    0, 0, 0},
        {F(8),  nullptr, B(WS_WA_OUT), 1024, 1024, 0,   1024, 0,    0, 0, 0},
        {F(10), F(9),  B(WS_WA_UP),   1024, 4096, 0,    4096, 0,    0, 0, 0},
        {F(11), nullptr, B(WS_WA_DOWN), 4096, 1024, 0,  1024, 0,    0, 0, 0},
        {F(13), F(12), B(WS_WB_IN),   1024, 1536, 0,    768,  0,    1, 0, 0},
        {F(13), F(12), B(WS_WB_V),    1024, 1536, 768,  768,  0,    0, 0, 0},
        {F(15), F(14), B(WS_WB_IN),   1024, 1024, 0,    768,  768,  1, 0, 0},
        {F(15), F(14), B(WS_WB_IN),   1024, 1024, 768,  256,  1536, 0, 0, 0},
        {F(18), nullptr, B(WS_WB_OUT), 1024, 1024, 0,   1024, 0,    0, 0, 0},
        {F(20), F(19), B(WS_WB_UP),   1024, 4096, 0,    4096, 0,    0, 0, 0},
        {F(21), nullptr, B(WS_WB_DOWN), 4096, 1024, 0,  1024, 0,    0, 0, 0},
    };
    int start = 0;
    for (int k = 0; k < NWD; ++k) { p.wd[k] = wd[k]; p.wd[k].start = start; start += (wd[k].K / 64) * (wd[k].ncols / 32); }
    p.nitems = start;
    p.nearly = 0; for (int k = 0; k < 6; ++k) p.nearly += (wd[k].K / 64) * (wd[k].ncols / 32);
    for (int d = 0; d < 32; ++d) p.inv[d] = 1.0f / powf(10000.0f, (float)d / 32.0f);
    if (hipMemsetAsync((char*)d_ws + WS_BAR, 0, 16384, stream) != hipSuccess) { fprintf(stderr, "kernel_launch: hipMemsetAsync failed\n"); return; }
    void* args[] = {&p};
    const hipError_t e = hipLaunchCooperativeKernel((const void*)fwd_kernel, dim3(256), dim3(NTHREADS), args, LDS_BYTES, stream);
    if (e != hipSuccess) fprintf(stderr, "kernel_launch: cooperative launch failed: %s\n", hipGetErrorString(e));
}
```
